# Optimizing an MI355X kernel written in HIP

```python
import math
import jax
import jax.numpy as jnp
from jax import lax
import numpy as np

D_MODEL = 4096
BATCH = 2
SEQ = 8192
DEPTH = 2

CTX_LEN = 256
GRID_W = 64
HEAD_DIM = 128
N_MIX_HEADS = D_MODEL // HEAD_DIM
A_HEADS = 3 * N_MIX_HEADS // 8
A_KV_HEADS = A_HEADS // 3
A_GROUP = A_HEADS // A_KV_HEADS
B_HEADS = (N_MIX_HEADS - A_HEADS) // 2
C_HEADS = N_MIX_HEADS - A_HEADS - B_HEADS
C_QK_DIM = HEAD_DIM // 2
HG_DK = HEAD_DIM
HG_DV = HEAD_DIM
A_W = A_HEADS * HEAD_DIM
B_W = B_HEADS * HG_DV
C_W = C_HEADS * HEAD_DIM
MIX_W = A_W + B_W + C_W
D_FF = ((8 * D_MODEL + 3 * 256 - 1) // (3 * 256)) * 256
ATTN_BLOCK = 128
HG_CHUNK = 64
ROPE_THETA = 10000.0
EPS = 1e-6

Q_SPLITS = (A_W, C_HEADS * 2 * C_QK_DIM, B_HEADS * HG_DK, B_W)
KV_SPLITS = (A_KV_HEADS * HEAD_DIM, A_KV_HEADS * HEAD_DIM, C_HEADS * 2 * C_QK_DIM, C_W,
             B_W, B_HEADS * HG_DK, B_HEADS * HG_DK)
Q_COLS = sum(Q_SPLITS)
IN_COLS = Q_COLS + sum(KV_SPLITS)

kernel_name = 'hybrid_headgroup_diffusion_block'


def _rms(x, gain=None):
    xf = x.astype(jnp.float32)
    y = xf * lax.rsqrt(jnp.mean(xf * xf, axis=-1, keepdims=True) + EPS)
    if gain is not None:
        y = y * gain.astype(jnp.float32)
    return y.astype(x.dtype)


def _split(a, sizes):
    return jnp.split(a, np.cumsum(sizes)[:-1].tolist(), axis=-1)


def _axial_rope(row, col, dim):
    half = dim // 2
    inv = ROPE_THETA ** (-jnp.arange(0, half, 2, dtype=jnp.float32) / half)
    ang = jnp.concatenate([row[:, None] * inv, col[:, None] * inv], axis=-1)
    return jnp.cos(ang), jnp.sin(ang)


def _rope(x, cos, sin):
    shp = (cos.shape[0],) + (1,) * (x.ndim - 3) + (cos.shape[1],)
    cos = cos.reshape(shp)
    sin = sin.reshape(shp)
    xf = x.astype(jnp.float32).reshape(x.shape[:-1] + (x.shape[-1] // 2, 2))
    x0, x1 = xf[..., 0], xf[..., 1]
    out = jnp.stack([x0 * cos - x1 * sin, x0 * sin + x1 * cos], axis=-1).reshape(x.shape)
    return out.astype(x.dtype)


def _sweep(q, fn):
    bsz, T = q.shape[:2]
    nb = T // ATTN_BLOCK
    qb = jnp.moveaxis(q.reshape((bsz, nb, ATTN_BLOCK) + q.shape[2:]), 1, 0)
    o = lax.map(fn, qb)
    return jnp.moveaxis(o, 0, 1).reshape((bsz, T) + o.shape[3:])


def _gqa(q, k, v):
    scale = q.shape[-1] ** -0.5

    def block(qb):
        s = jnp.einsum('bqkgd,bskd->bkgqs', qb, k).astype(jnp.float32) * scale
        p = jax.nn.softmax(s, axis=-1).astype(v.dtype)
        return jnp.einsum('bkgqs,bskd->bqkgd', p, v)

    return _sweep(q, block)


def _diff(q, k, v, lam):
    scale = q.shape[-1] ** -0.5

    def block(qb):
        s = jnp.einsum('bqhmd,bshmd->bhmqs', qb, k).astype(jnp.float32) * scale
        p = jax.nn.softmax(s, axis=-1)
        w = (p[:, :, 0] - lam * p[:, :, 1]).astype(v.dtype)
        return jnp.einsum('bhqs,bshd->bqhd', w, v)

    return _sweep(q, block)


def _logf(z, lb):
    zf = z.astype(jnp.float32).reshape(z.shape[0], z.shape[1], B_HEADS, HG_DK)
    return jnp.logaddexp(jnp.log(lb), jnp.log1p(-lb) + jax.nn.log_sigmoid(zf))


def _gla_scan(q, v, logf, s0):
    bsz, T, H, _ = q.shape
    n = T // HG_CHUNK

    def chunks(a):
        return a.reshape(bsz, n, HG_CHUNK, H, a.shape[-1]).transpose(1, 0, 3, 2, 4)

    mask = jnp.tril(jnp.ones((HG_CHUNK, HG_CHUNK), dtype=bool))[:, :, None]

    def step(S, inp):
        qc, vc, gc = inp
        kc = -jnp.expm1(gc)
        b = jnp.cumsum(gc, axis=2)
        rel = b[:, :, :, None, :] - b[:, :, None, :, :]
        dec = jnp.exp(jnp.where(mask, rel, -jnp.inf))
        a = jnp.einsum('bhtd,bhsd,bhtsd->bhts', qc, kc, dec)
        o = jnp.einsum('bhts,bhsv->bhtv', a, vc) + jnp.einsum('bhtd,bhdv->bhtv', qc * jnp.exp(b), S)
        b_end = b[:, :, -1:, :]
        S = jnp.exp(b_end[:, :, 0, :])[..., None] * S + jnp.einsum('bhsd,bhsv->bhdv', kc * jnp.exp(b_end - b), vc)
        return S, o

    S, o = lax.scan(step, s0, (chunks(q), chunks(v), chunks(logf)))
    return o.transpose(1, 0, 3, 2, 4).reshape(bsz, T, H, v.shape[-1]), S


def _final_state(v, logf):
    b = jnp.cumsum(logf, axis=1)
    w = -jnp.expm1(logf) * jnp.exp(b[:, -1:] - b)
    return jnp.einsum('blhd,blhv->bhdv', w, v)


def _swiglu(h, w_gate, w_up, w_down):
    return (jax.nn.silu(h @ w_gate) * (h @ w_up)) @ w_down


def _layer(x, y, c, c_ctx, rope_a, rope_c, lb, lam_init, last,
           w_ada, b_ada, w_in, w_out, aq_g, ak_g, ho_g, dq_g, dk_g, d_lam, do_g,
           w_gate, w_up, w_down):
    bsz, T, D = x.shape
    L = y.shape[1]
    dt = x.dtype
    f32 = jnp.float32
    flip = lambda a: jnp.flip(a, axis=1)

    mx = [m[:, None, :] for m in jnp.split(jax.nn.silu(c) @ w_ada + b_ada, 6, axis=-1)]
    n_y = 2 if last else 6
    my = jnp.split(jax.nn.silu(c_ctx) @ w_ada[:, :n_y * D] + b_ada[:n_y * D], n_y, axis=-1)

    hx = _rms(x) * (1 + mx[1]) + mx[0]
    hy = _rms(y) * (1 + my[1]) + my[0]

    xa_q, xc_q, xb_q, xb_g, xa_k, xa_v, xc_k, xc_v, xb_i, xb_ff, xb_fb = _split(hx @ w_in, Q_SPLITS + KV_SPLITS)
    if last:
        yparts = _split(hy @ w_in[:, Q_COLS:], KV_SPLITS)
    else:
        yparts = _split(hy @ w_in, Q_SPLITS + KV_SPLITS)
        ya_q, yc_q, yb_q, yb_g = yparts[:4]
        yparts = yparts[4:]
    ya_k, ya_v, yc_k, yc_v, yb_i, yb_ff, yb_fb = yparts

    ka_x = _rope(_rms(xa_k.reshape(bsz, T, A_KV_HEADS, HEAD_DIM), ak_g), *rope_a)
    ka_y = _rms(ya_k.reshape(bsz, L, A_KV_HEADS, HEAD_DIM), ak_g)
    va_x = xa_v.reshape(bsz, T, A_KV_HEADS, HEAD_DIM)
    va_y = ya_v.reshape(bsz, L, A_KV_HEADS, HEAD_DIM)
    qa_x = _rope(_rms(xa_q.reshape(bsz, T, A_KV_HEADS, A_GROUP, HEAD_DIM), aq_g), *rope_a)
    oa_x = _gqa(qa_x, jnp.concatenate([ka_y, ka_x], axis=1),
                jnp.concatenate([va_y, va_x], axis=1)).reshape(bsz, T, A_W)

    dl = d_lam.astype(f32)
    lam = jnp.exp(jnp.sum(dl[0] * dl[1])) - jnp.exp(jnp.sum(dl[2] * dl[3])) + lam_init
    qc_x = _rope(_rms(xc_q.reshape(bsz, T, C_HEADS, 2, C_QK_DIM), dq_g), *rope_c)
    kc_x = _rope(_rms(xc_k.reshape(bsz, T, C_HEADS, 2, C_QK_DIM), dk_g), *rope_c)
    kc_y = _rms(yc_k.reshape(bsz, L, C_HEADS, 2, C_QK_DIM), dk_g)
    vc_x = xc_v.reshape(bsz, T, C_HEADS, HEAD_DIM)
    vc_y = yc_v.reshape(bsz, L, C_HEADS, HEAD_DIM)
    oc_x = _diff(qc_x, jnp.concatenate([kc_y, kc_x], axis=1), jnp.concatenate([vc_y, vc_x], axis=1), lam)
    oc_x = (_rms(oc_x, do_g) * (1.0 - lam_init)).reshape(bsz, T, C_W)

    gf_x, gb_x = _logf(xb_ff, lb[0]), _logf(xb_fb, lb[1])
    gf_y, gb_y = _logf(yb_ff, lb[0]), _logf(yb_fb, lb[1])
    ib_x = yb_i if False else xb_i.astype(f32).reshape(bsz, T, B_HEADS, HG_DV)
    ib_y = yb_i.astype(f32).reshape(bsz, L, B_HEADS, HG_DV)
    qb_x = jax.nn.silu(xb_q.astype(f32)).reshape(bsz, T, B_HEADS, HG_DK)
    if last:
        s_f = _final_state(ib_y, gf_y)
        s_b = _final_state(flip(ib_y), flip(gb_y))
    else:
        s0 = jnp.zeros((bsz, B_HEADS, HG_DK, HG_DV), f32)
        qb_y = jax.nn.silu(yb_q.astype(f32)).reshape(bsz, L, B_HEADS, HG_DK)
        ob_yf, s_f = _gla_scan(qb_y, ib_y, gf_y, s0)
        ob_yb, s_b = _gla_scan(flip(qb_y), flip(ib_y), flip(gb_y), s0)
        ob_y = ob_yf + flip(ob_yb)
    ob_xf, _ = _gla_scan(qb_x, ib_x, gf_x, s_f)
    ob_xb, _ = _gla_scan(flip(qb_x), flip(ib_x), flip(gb_x), s_b)
    ob_x = _rms(ob_xf + flip(ob_xb), ho_g) * jax.nn.silu(xb_g.astype(f32)).reshape(bsz, T, B_HEADS, HG_DV)
    ob_x = ob_x.reshape(bsz, T, B_W).astype(dt)

    mix = jnp.concatenate([oa_x.astype(dt), ob_x, oc_x.astype(dt)], axis=-1) @ w_out
    x = x + mx[2] * mix
    x = x + mx[5] * _swiglu(_rms(x) * (1 + mx[4]) + mx[3], w_gate, w_up, w_down)
    if last:
        return x, None

    qa_y = _rms(ya_q.reshape(bsz, L, A_KV_HEADS, A_GROUP, HEAD_DIM), aq_g)
    oa_y = _gqa(qa_y, ka_y, va_y).reshape(bsz, L, A_W)
    qc_y = _rms(yc_q.reshape(bsz, L, C_HEADS, 2, C_QK_DIM), dq_g)
    oc_y = (_rms(_diff(qc_y, kc_y, vc_y, lam), do_g) * (1.0 - lam_init)).reshape(bsz, L, C_W)
    ob_y = _rms(ob_y, ho_g) * jax.nn.silu(yb_g.astype(f32)).reshape(bsz, L, B_HEADS, HG_DV)
    ob_y = ob_y.reshape(bsz, L, B_W).astype(dt)
    mix_y = jnp.concatenate([oa_y.astype(dt), ob_y, oc_y.astype(dt)], axis=-1) @ w_out
    y = y + my[2] * mix_y
    y = y + my[5] * _swiglu(_rms(y) * (1 + my[4]) + my[3], w_gate, w_up, w_down)
    return x, y


def setup_inputs(seed: int = 0) -> dict:
    key = jax.random.key(seed)
    ks = jax.random.split(key, 20)

    def nrm(k, shape, s):
        return jax.random.normal(k, shape, jnp.float32) * s

    return {
        'x': nrm(ks[0], (BATCH, SEQ, D_MODEL), 1.0),
        'c': nrm(ks[1], (BATCH, D_MODEL), 1.0),
        'ctx': nrm(ks[2], (BATCH, CTX_LEN, D_MODEL), 1.0),
        'c_ctx': nrm(ks[3], (D_MODEL,), 1.0),
        'w_ada': nrm(ks[4], (DEPTH, D_MODEL, 6 * D_MODEL), 0.5 * D_MODEL ** -0.5),
        'b_ada': nrm(ks[5], (DEPTH, 6 * D_MODEL), 0.02),
        'w_in': nrm(ks[6], (DEPTH, D_MODEL, IN_COLS), D_MODEL ** -0.5),
        'w_out': nrm(ks[7], (DEPTH, MIX_W, D_MODEL), MIX_W ** -0.5),
        'attn_q_gain': 1.0 + nrm(ks[8], (DEPTH, HEAD_DIM), 0.02),
        'attn_k_gain': 1.0 + nrm(ks[9], (DEPTH, HEAD_DIM), 0.02),
        'hgrn_lb_logits': nrm(ks[10], (DEPTH, 2, B_HEADS * HG_DK), 0.5),
        'hgrn_o_gain': 1.0 + nrm(ks[11], (DEPTH, HG_DV), 0.02),
        'diff_q_gain': 1.0 + nrm(ks[12], (DEPTH, C_QK_DIM), 0.02),
        'diff_k_gain': 1.0 + nrm(ks[13], (DEPTH, C_QK_DIM), 0.02),
        'diff_lambda': nrm(ks[14], (DEPTH, 4, C_QK_DIM), 0.1),
        'diff_o_gain': 1.0 + nrm(ks[15], (DEPTH, HEAD_DIM), 0.02),
        'w_gate': nrm(ks[16], (DEPTH, D_MODEL, D_FF), D_MODEL ** -0.5),
        'w_up': nrm(ks[17], (DEPTH, D_MODEL, D_FF), D_MODEL ** -0.5),
        'w_down': nrm(ks[18], (DEPTH, D_FF, D_MODEL), D_FF ** -0.5),
    }


def reference(x, c, ctx, c_ctx, w_ada, b_ada, w_in, w_out, attn_q_gain, attn_k_gain,
              hgrn_lb_logits, hgrn_o_gain, diff_q_gain, diff_k_gain, diff_lambda, diff_o_gain,
              w_gate, w_up, w_down):
    T = x.shape[1]
    rows = T // GRID_W
    row = jnp.repeat(jnp.arange(rows, dtype=jnp.float32), GRID_W)
    col = jnp.tile(jnp.arange(GRID_W, dtype=jnp.float32), rows)
    rope_a = _axial_rope(row, col, HEAD_DIM)
    rope_c = _axial_rope(row, col, C_QK_DIM)

    sm = jax.nn.softmax(hgrn_lb_logits.astype(jnp.float32), axis=0)
    lb = jnp.concatenate([jnp.zeros_like(sm[:1]), jnp.cumsum(sm[1:], axis=0)], axis=0)
    lb = lb.reshape(DEPTH, 2, B_HEADS, HG_DK)

    y = ctx
    for l in range(DEPTH):
        lam_init = 0.8 - 0.6 * math.exp(-0.3 * l)
        x, y = _layer(x, y, c, c_ctx, rope_a, rope_c, lb[l], lam_init, l == DEPTH - 1,
                      w_ada[l], b_ada[l], w_in[l], w_out[l], attn_q_gain[l], attn_k_gain[l],
                      hgrn_o_gain[l], diff_q_gain[l], diff_k_gain[l], diff_lambda[l], diff_o_gain[l],
                      w_gate[l], w_up[l], w_down[l])
    return x
```

```cpp
#include <hip/hip_runtime.h>
#include <cstdio>
#include <cstdint>
__device__ __forceinline__ int opaque_lane() { int t = __builtin_amdgcn_mbcnt_hi(~0u, __builtin_amdgcn_mbcnt_lo(~0u, 0u)); asm volatile("" : "+v"(t)); return t; }
__device__ __forceinline__ int opaque_s(int v) { asm volatile("" : "+s"(v)); return v; }
namespace pg8 {
#define PG8_LAS __attribute__((address_space(3)))
typedef unsigned short bf16_t;
typedef short bf16x8 __attribute__((ext_vector_type(8)));
typedef float f32x4 __attribute__((ext_vector_type(4)));
typedef unsigned u32x4 __attribute__((ext_vector_type(4)));
constexpr int BM = 256, BK = 64, HALF = 128, HTB = HALF * BK * 2  , STAGE_BYTES = 8 * HTB, NXCD = 8, WGM = 8;

__host__ __device__ __forceinline__ int lds_byte(int r, int c) { const int st = (r >> 4) * 2 + (c >> 5), rr = r & 15, cc = c & 31, ob = rr * 64 + cc * 2; return st * 1024 + (ob ^ (((ob >> 9) & 1) << 5)); }
__host__ __device__ __forceinline__ void stage_rc(int b, int& R, int& C) { const int st = b / 1024, sb = b % 1024, swz = sb ^ (((sb >> 9) & 1) << 5); R = (st >> 1) * 16 + swz / 64; C = (st & 1) * 32 + (swz % 64) / 2; }
__host__ __device__ __forceinline__ int perm32(int rho) { const int n = rho >> 4, i = rho & 15; return 8 * (i >> 2) + 4 * n + (i & 3); }

struct Unit { int pm, pn, kt0, nt, sl; };
struct Gemm { const bf16_t* A; const bf16_t* Bt; int M, N, K; };

struct StaticOrder {
    int nM, nN, nwg, G, c, wgm;
    __host__ __device__ void init(int M, int N, int G_, int c_, int wgm_ = WGM) { nM = M / BM; nN = N / BM; nwg = nM * nN; G = G_; c = c_; wgm = wgm_; }
    __host__ __device__ bool next(int i, Unit& u) const {
        const long L = (long)i * G + c; if (L >= nwg) return false;
        int wgid = (int)L; { const int q = nwg / NXCD, r = nwg % NXCD, xcd = wgid % NXCD, off = wgid / NXCD; wgid = (xcd < r ? xcd * (q + 1) : r * (q + 1) + (xcd - r) * q) + off; }
        const int nig = wgm * nN, gid = wgid / nig, fm = gid * wgm, gsz = (nM - fm) < wgm ? (nM - fm) : wgm;
        u.pm = fm + ((wgid % nig) % gsz); u.pn = (wgid % nig) / gsz; u.kt0 = 0; u.nt = 0; u.sl = 0; return true;
    }
    __device__ __forceinline__ void a_ready(const Unit&) const {}
    __device__ __forceinline__ void done(const Unit&) const {}
};
struct PanelOrder {
    StaticOrder so; int skip, extra, slices, ktiles;
    __host__ __device__ void init(int N, int G_, int c_, int skip_, int extra_, int slices_ = 0, int ktiles_ = 0, int wgm_ = WGM) { skip = skip_; extra = extra_; slices = slices_; ktiles = ktiles_; so.init(skip_ ? 16384 : 16896, N, G_, c_, wgm_); }
    __host__ __device__ bool next(int i, Unit& u) const {
        if (so.next(i, u)) { if (skip) u.pm += 1 + (u.pm >= 32 ? 1 : 0); return true; }
        const long L = (long)i * so.G + so.c - so.nwg;
        if (slices) { if (L >= 2 * so.nN * 8) return false;
            const int tl = (int)(L >> 3), sl = (int)(L & 7); u.pm = (tl >= so.nN) ? 33 : 0; u.pn = tl % so.nN;
            const int base = (ktiles / 16) * 2, rem = (ktiles - base * 8) / 2;
            u.nt = base + (sl < rem ? 2 : 0); u.kt0 = sl * base + 2 * (sl < rem ? sl : rem); u.sl = sl; return true; }
        if (L >= extra) return false;
        u.pm = (L >= 29) ? 33 : 0; u.pn = 21 + (int)(L % 29); u.kt0 = 0; u.nt = 0; u.sl = 0; return true;
    }
    __device__ __forceinline__ void a_ready(const Unit&) const {}
    __device__ __forceinline__ void done(const Unit&) const {}
};

typedef float f32x2 __attribute__((ext_vector_type(2)));
typedef __bf16 bf16x2_c __attribute__((ext_vector_type(2)));
__device__ __forceinline__ unsigned cvt_pk_bf16(float lo, float hi) { f32x2 v = {lo, hi}; bf16x2_c b = __builtin_convertvector(v, bf16x2_c); return __builtin_bit_cast(unsigned, b); }
constexpr int ROWS_B = 8448, PAN_B = 33;
struct EpiStore {
    static constexpr bool PERM = true, AFTER_DRAIN = false;
    bf16_t* O; int ldc;
    __device__ __forceinline__ void operator()(const f32x4 (&acc)[2][2][4][2], const Unit& u, int wr, int wc, int fr, int fq) const {
        const int row0 = u.pm * BM + wr * 64 + fr, col0 = u.pn * BM + wc * 32 + 8 * fq;
#pragma unroll
        for (int ai = 0; ai < 2; ++ai)
#pragma unroll
            for (int m = 0; m < 4; ++m) { bf16_t* rowp = O + (size_t)(row0 + ai * HALF + m * 16) * ldc + col0;
#pragma unroll
                for (int bj = 0; bj < 2; ++bj) { const f32x4 v0 = acc[ai][bj][m][0], v1 = acc[ai][bj][m][1];
                    u32x4 w; w.x = cvt_pk_bf16(v0[0], v0[1]); w.y = cvt_pk_bf16(v0[2], v0[3]); w.z = cvt_pk_bf16(v1[0], v1[1]); w.w = cvt_pk_bf16(v1[2], v1[3]);
                    *(u32x4*)(rowp + bj * HALF) = w; } }
    }
};
struct EpiInproj {
    static constexpr bool PERM = true, AFTER_DRAIN = false;
    bf16_t* O; int ldc; const float* aq_g; const float* ak_g; const float* dq_g; const float* dk_g; PG8_LAS float* xs;
    __device__ __forceinline__ void operator()(const f32x4 (&acc)[2][2][4][2], const Unit& u, int wr, int wc, int fr, int fq) const {
        const int row0 = u.pm * BM + wr * 64 + fr, col0 = u.pn * BM + wc * 32 + 8 * fq;
        const int pn = u.pn, kind = pn < 6 ? 1 : pn < 11 ? 2 : (pn == 21 || pn == 22) ? 3 : (pn >= 25 && pn < 30) ? 4 : 0;
        if (kind == 0) {
#pragma unroll
            for (int ai = 0; ai < 2; ++ai)
#pragma unroll
                for (int m = 0; m < 4; ++m) { bf16_t* rowp = O + (size_t)(row0 + ai * HALF + m * 16) * ldc + col0;
#pragma unroll
                    for (int bj = 0; bj < 2; ++bj) { const f32x4 v0 = acc[ai][bj][m][0], v1 = acc[ai][bj][m][1];
                        u32x4 w; w.x = cvt_pk_bf16(v0[0], v0[1]); w.y = cvt_pk_bf16(v0[2], v0[3]); w.z = cvt_pk_bf16(v1[0], v1[1]); w.w = cvt_pk_bf16(v1[2], v1[3]);
                        *(u32x4*)(rowp + bj * HALF) = w; } }
            return;
        }
        const bool isA = (kind & 1) != 0, isq = kind <= 2;
#pragma unroll
        for (int ai = 0; ai < 2; ++ai)
#pragma unroll
            for (int m = 0; m < 4; ++m)
#pragma unroll
                for (int bj = 0; bj < 2; ++bj) { const f32x4 a = acc[ai][bj][m][0], c = acc[ai][bj][m][1];
                    float q = (a[0] * a[0] + a[1] * a[1]) + (a[2] * a[2] + a[3] * a[3]) + (c[0] * c[0] + c[1] * c[1]) + (c[2] * c[2] + c[3] * c[3]);
                    q += __int_as_float(__builtin_amdgcn_ds_swizzle(__float_as_int(q), 0x1f | (16 << 10)));
                    { auto rr = __builtin_amdgcn_permlane32_swap(__float_as_uint(q), __float_as_uint(q), false, false); q = __uint_as_float(rr[0]) + __uint_as_float(rr[1]); }
                    if (fq == 0) xs[((((wr * 2 + ai) * 4 + m) * 16 + fr) * 2 + bj) * 4 + wc] = q; }
        asm volatile("s_waitcnt lgkmcnt(0)\n\ts_barrier" ::: "memory");
        const float* gp = kind == 1 ? aq_g : kind == 3 ? ak_g : kind == 2 ? dq_g : dk_g;
        const int ch = isA ? (32 * wc + 8 * fq) : ((32 * wc + 8 * fq) & 63);
        const f32x4 g0 = *(const f32x4*)(gp + ch), g1 = *(const f32x4*)(gp + ch + 4);
        const float qs = isq ? (isA ? 0.12751743f : 0.18033688f) : 1.0f;
        const bool latent = (u.pm % PAN_B) != 0;
        const bool use_row = isA ? (wc < 2) : ((wc & 1) == 0);
        float inv[4];
#pragma unroll
        for (int k = 0; k < 4; ++k) { const int p = ch / 2 + k;
            inv[k] = isA ? __builtin_amdgcn_exp2f(-(float)(2 * (p & 31)) * (13.287712379549449f / 64.0f)) : __builtin_amdgcn_exp2f(-(float)(2 * (p & 15)) * (13.287712379549449f / 32.0f)); }
#pragma unroll
        for (int ai = 0; ai < 2; ++ai)
#pragma unroll
            for (int m = 0; m < 4; ++m) {
                const int row = row0 + ai * HALF + m * 16, t = row % ROWS_B - 256;
                float cs[4], sn[4];
#pragma unroll
                for (int k = 0; k < 4; ++k) { cs[k] = 1.f; sn[k] = 0.f; }
                if (latent) { const float pos = (float)(use_row ? (t >> 6) : (t & 63));
#pragma unroll
                    for (int k = 0; k < 4; ++k) { float rv = pos * inv[k] * 0.15915494309189535f; rv -= floorf(rv); cs[k] = __builtin_amdgcn_cosf(rv); sn[k] = __builtin_amdgcn_sinf(rv); } }
                bf16_t* rowp = O + (size_t)row * ldc + col0;
#pragma unroll
                for (int bj = 0; bj < 2; ++bj) {
                    const f32x4 t4 = *(const PG8_LAS f32x4*)(xs + ((((wr * 2 + ai) * 4 + m) * 16 + fr) * 2 + bj) * 4);
                    const float ssum = isA ? ((t4[0] + t4[1]) + (t4[2] + t4[3])) : (wc < 2 ? t4[0] + t4[1] : t4[2] + t4[3]);
                    const float rstd = __builtin_amdgcn_rsqf(ssum * (isA ? 1.f / 128.f : 1.f / 64.f) + 1e-6f) * qs;
                    const f32x4 y0 = acc[ai][bj][m][0] * g0 * rstd, y1 = acc[ai][bj][m][1] * g1 * rstd;
                    u32x4 w;
                    w.x = cvt_pk_bf16(y0[0] * cs[0] - y0[1] * sn[0], y0[0] * sn[0] + y0[1] * cs[0]); w.y = cvt_pk_bf16(y0[2] * cs[1] - y0[3] * sn[1], y0[2] * sn[1] + y0[3] * cs[1]);
                    w.z = cvt_pk_bf16(y1[0] * cs[2] - y1[1] * sn[2], y1[0] * sn[2] + y1[1] * cs[2]); w.w = cvt_pk_bf16(y1[2] * cs[3] - y1[3] * sn[3], y1[2] * sn[3] + y1[3] * cs[3]);
                    *(u32x4*)(rowp + bj * HALF) = w; }
            }
    }
};
struct EpiSwiglu {
    static constexpr bool PERM = true, AFTER_DRAIN = false;
    bf16_t* O; int ldc;
    __device__ __forceinline__ void operator()(const f32x4 (&acc)[2][2][4][2], const Unit& u, int wr, int wc, int fr, int fq) const {
        const int row0 = u.pm * BM + wr * 64 + fr, col0 = u.pn * HALF + wc * 32 + 8 * fq;
#pragma unroll
        for (int ai = 0; ai < 2; ++ai)
#pragma unroll
            for (int m = 0; m < 4; ++m) { bf16_t* rowp = O + (size_t)(row0 + ai * HALF + m * 16) * ldc + col0;
                float h[8];
#pragma unroll
                for (int n = 0; n < 2; ++n)
#pragma unroll
                    for (int i = 0; i < 4; ++i) { const float g = acc[ai][0][m][n][i], up = acc[ai][1][m][n][i];
                        h[n * 4 + i] = g * __builtin_amdgcn_rcpf(1.0f + __expf(-g)) * up; }
                u32x4 w; w.x = cvt_pk_bf16(h[0], h[1]); w.y = cvt_pk_bf16(h[2], h[3]); w.z = cvt_pk_bf16(h[4], h[5]); w.w = cvt_pk_bf16(h[6], h[7]);
                *(u32x4*)rowp = w; }
    }
};
typedef unsigned u32x2_e __attribute__((ext_vector_type(2)));
struct EpiResGate {
    static constexpr bool PERM = false, AFTER_DRAIN = false;
    const float* res; float* out; const float* modl; int goff; int final_out; int res_in; const float* xin; const float* cin; float* part;
    __device__ __forceinline__ void operator()(const f32x4 (&acc)[2][2][4][2], const Unit& u, int wr, int wc, int fr, int fq) const {
        const int b = u.pm / PAN_B, pl = u.pm % PAN_B, isctx = (pl == 0);
        if (final_out && isctx) return;
        const float* gate = modl + (isctx ? 2 : b) * 24576 + goff;
        const int col0 = u.pn * BM + wc * 32 + 4 * fq;
        f32x4 gv[2][2];
#pragma unroll
        for (int bj = 0; bj < 2; ++bj)
#pragma unroll
            for (int n = 0; n < 2; ++n) gv[bj][n] = *(const f32x4*)(gate + col0 + bj * HALF + n * 16);
        const float* rbase = isctx ? cin + (size_t)b * 256 * 4096 : xin + ((size_t)b * 8192 + (size_t)(pl - 1) * 256) * 4096;
        float* obase = out + ((size_t)b * 8192 + (size_t)(pl - 1) * 256) * 4096;
        const bf16_t* resb = (const bf16_t*)res + (size_t)u.pm * BM * 4096; bf16_t* outb = (bf16_t*)out + (size_t)u.pm * BM * 4096;
#define ERG_OFF(ai, m, bj, n) ((size_t)((ai) * HALF + wr * 64 + (m) * 16 + fr) * 4096 + col0 + (bj) * HALF + (n) * 16)
        if (u.nt) {
            float* pb = part + ((size_t)(u.sl * 512 + b * 256) * 4096);
#pragma unroll
            for (int ai = 0; ai < 2; ++ai)
#pragma unroll
                for (int m = 0; m < 4; ++m)
#pragma unroll
                    for (int bj = 0; bj < 2; ++bj)
#pragma unroll
                        for (int n = 0; n < 2; ++n) *(f32x4*)(pb + ERG_OFF(ai, m, bj, n)) = gv[bj][n] * acc[ai][bj][m][n];
            return;
        }
        if (res_in) {
#pragma unroll
            for (int ai = 0; ai < 2; ++ai)
#pragma unroll
                for (int mh = 0; mh < 2; ++mh) {
                    f32x4 x[2][2][2];
#pragma unroll
                    for (int m = 0; m < 2; ++m)
#pragma unroll
                        for (int bj = 0; bj < 2; ++bj)
#pragma unroll
                            for (int n = 0; n < 2; ++n) x[m][bj][n] = *(const f32x4*)(rbase + ERG_OFF(ai, 2 * mh + m, bj, n));
#pragma unroll
                    for (int m = 0; m < 2; ++m)
#pragma unroll
                        for (int bj = 0; bj < 2; ++bj)
#pragma unroll
                            for (int n = 0; n < 2; ++n) { const f32x4 y = x[m][bj][n] + gv[bj][n] * acc[ai][bj][2 * mh + m][n];
                                u32x2_e w; w.x = cvt_pk_bf16(y[0], y[1]); w.y = cvt_pk_bf16(y[2], y[3]); *(u32x2_e*)(outb + ERG_OFF(ai, 2 * mh + m, bj, n)) = w; }
                }
            return;
        }
        {
#pragma unroll
            for (int ai = 0; ai < 2; ++ai) {
                u32x2_e xb[4][2][2];
#pragma unroll
                for (int m = 0; m < 4; ++m)
#pragma unroll
                    for (int bj = 0; bj < 2; ++bj)
#pragma unroll
                        for (int n = 0; n < 2; ++n) xb[m][bj][n] = *(const u32x2_e*)(resb + ERG_OFF(ai, m, bj, n));
#pragma unroll
                for (int m = 0; m < 4; ++m)
#pragma unroll
                    for (int bj = 0; bj < 2; ++bj)
#pragma unroll
                        for (int n = 0; n < 2; ++n) { const u32x2_e t = xb[m][bj][n];
                            const f32x4 x = (f32x4){__uint_as_float(t.x << 16), __uint_as_float(t.x & 0xffff0000u), __uint_as_float(t.y << 16), __uint_as_float(t.y & 0xffff0000u)};
                            const f32x4 y = x + gv[bj][n] * acc[ai][bj][m][n];
                            if (final_out) *(f32x4*)(obase + ERG_OFF(ai, m, bj, n)) = y;
                            else { u32x2_e w; w.x = cvt_pk_bf16(y[0], y[1]); w.y = cvt_pk_bf16(y[2], y[3]); *(u32x2_e*)(outb + ERG_OFF(ai, m, bj, n)) = w; } }
            }
        }
#undef ERG_OFF
    }
};
template <class Epi, class Sched, bool ALIGN_EPI = false, bool SP2 = false>
__device__ __forceinline__ void gemm_phase(PG8_LAS unsigned char* lds, const Gemm g, const Sched& S, const Epi& E, const int wid) {
    const int lane = opaque_lane(), tid = wid * 64 + lane, wr = wid >> 2, wc = wid & 3, fr = lane & 15, fq = lane >> 4;
    const int K = g.K, nt = K / BK;
    unsigned voffA[2], voffB[2];
#pragma unroll
    for (int i = 0; i < 2; ++i) { int R, C; stage_rc(tid * 16 + i * 8192, R, C); const int Rb = Epi::PERM ? ((R & ~31) + perm32(R & 31)) : R;
        voffA[i] = (unsigned)(R * K + C) * 2u; voffB[i] = (unsigned)(Rb * K + C) * 2u; }
    const size_t kstep = (size_t)(BK * 2);
    const size_t hstep = (size_t)HALF * K * 2;
    const size_t tstep = 2 * hstep;
    const unsigned ldsw = (unsigned)wid * 1024u;
    const int aoff = lds_byte(wr * 64 + fr, fq * 8), boff = lds_byte(wc * 32 + fr, fq * 8);
#define PG8_SA(b, h) (((b) * 2 + (h)) * HTB)
#define PG8_SB(b, h) ((4 + (b) * 2 + (h)) * HTB)
#define PG8_STAGE(bufoff, gbase, voff) do { _Pragma("unroll") for (int _i = 0; _i < 2; ++_i) \
        __builtin_amdgcn_global_load_lds((const unsigned*)((const char*)(gbase) + (voff)[_i]), (PG8_LAS unsigned*)(lds + (bufoff) + ldsw + _i * 8192), 16, 0, 0); } while (0)
#define PG8_LDA(dst, b, h) do { _Pragma("unroll") for (int m = 0; m < 4; ++m) _Pragma("unroll") for (int k = 0; k < 2; ++k) dst[m][k] = *(const PG8_LAS bf16x8*)(lds + PG8_SA(b, h) + aoff + m * 2048 + k * 1024); } while (0)
#define PG8_LDB(dst, b, h) do { _Pragma("unroll") for (int n = 0; n < 2; ++n) _Pragma("unroll") for (int k = 0; k < 2; ++k) dst[n][k] = *(const PG8_LAS bf16x8*)(lds + PG8_SB(b, h) + boff + n * 2048 + k * 1024); } while (0)
#define PG8_MMA(ai, bj, At, Bt) do { __builtin_amdgcn_s_setprio(1); _Pragma("unroll") for (int m = 0; m < 4; ++m) _Pragma("unroll") for (int n = 0; n < 2; ++n) _Pragma("unroll") for (int k = 0; k < 2; ++k) \
        acc[ai][bj][m][n] = __builtin_amdgcn_mfma_f32_16x16x32_bf16(Bt[n][k], At[m][k], acc[ai][bj][m][n], 0, 0, 0); __builtin_amdgcn_s_setprio(0); } while (0)
#define PG8_WAIT_V(n) asm volatile("s_waitcnt vmcnt(" #n ")" ::: "memory")
#define PG8_WAIT_L(n) asm volatile("s_waitcnt lgkmcnt(" #n ")" ::: "memory")
#define PG8_BAR __builtin_amdgcn_s_barrier()
#define PG8_SCHED __builtin_amdgcn_sched_barrier(0)
    Unit cur, nxt; int ui = 0;
    if (!S.next(0, cur)) return;
    f32x4 acc[2][2][4][2];
#pragma unroll
    for (int a = 0; a < 2; ++a)
#pragma unroll
        for (int b = 0; b < 2; ++b)
#pragma unroll
            for (int m = 0; m < 4; ++m)
#pragma unroll
                for (int n = 0; n < 2; ++n) acc[a][b][m][n] = (f32x4){0.f, 0.f, 0.f, 0.f};
    bf16x8 At[4][2], B0[2][2], B1[2][2];
    const char* cA = (const char*)g.A + (size_t)cur.pm * tstep + (size_t)cur.kt0 * kstep; const char* cB = (const char*)g.Bt + (size_t)cur.pn * tstep + (size_t)cur.kt0 * kstep;
    int cnt = cur.nt ? cur.nt : nt;
    S.a_ready(cur);
    if constexpr (SP2) {
        PG8_STAGE(PG8_SB(0, 0), cB, voffB); PG8_STAGE(PG8_SB(0, 1), cB + hstep, voffB); PG8_STAGE(PG8_SA(0, 0), cA, voffA); PG8_STAGE(PG8_SA(0, 1), cA + hstep, voffA);
        if (wr == 1) PG8_BAR;
        PG8_WAIT_V(2); PG8_BAR;
        PG8_STAGE(PG8_SB(1, 0), cB + kstep, voffB); PG8_STAGE(PG8_SA(1, 0), cA + kstep, voffA); PG8_STAGE(PG8_SB(1, 1), cB + hstep + kstep, voffB);
        PG8_WAIT_V(6); PG8_BAR;
    } else {
        PG8_STAGE(PG8_SB(0, 0), cB, voffB); PG8_STAGE(PG8_SA(0, 0), cA, voffA); PG8_STAGE(PG8_SB(0, 1), cB + hstep, voffB); PG8_STAGE(PG8_SA(0, 1), cA + hstep, voffA);
        if (wr == 1) PG8_BAR;
        PG8_WAIT_V(4); PG8_BAR;
        PG8_STAGE(PG8_SB(1, 0), cB + kstep, voffB); PG8_STAGE(PG8_SA(1, 0), cA + kstep, voffA); PG8_STAGE(PG8_SB(1, 1), cB + hstep + kstep, voffB);
        PG8_WAIT_V(6); PG8_BAR;
    }
    for (;;) {
        const bool has_next = S.next(ui + 1, nxt);
        const char* nA = has_next ? (const char*)g.A + (size_t)nxt.pm * tstep + (size_t)nxt.kt0 * kstep : cA; const char* nB = has_next ? (const char*)g.Bt + (size_t)nxt.pn * tstep + (size_t)nxt.kt0 * kstep : cB;
        for (int t = 0; t < cnt; t += 2) {
            const bool last = (t == cnt - 2);
            const char* a1 = cA + (size_t)(t + 1) * kstep;
            const char* a2 = last ? nA : cA + (size_t)(t + 2) * kstep; const char* b2 = last ? nB : cB + (size_t)(t + 2) * kstep;
            const char* a3 = a2 + kstep; const char* b3 = b2 + kstep;
            if (last && has_next) S.a_ready(nxt);
            if constexpr (SP2) {
            PG8_LDB(B0, 0, 0); PG8_LDB(B1, 0, 1); PG8_SCHED; PG8_LDA(At, 0, 0); PG8_STAGE(PG8_SA(1, 1), a1 + hstep, voffA);
            PG8_WAIT_V(8); PG8_WAIT_L(0); PG8_BAR; PG8_MMA(0, 0, At, B0); PG8_MMA(0, 1, At, B1); PG8_BAR; PG8_SCHED;
            PG8_LDA(At, 0, 1); PG8_STAGE(PG8_SB(0, 0), b2, voffB); PG8_STAGE(PG8_SB(0, 1), b2 + hstep, voffB); PG8_STAGE(PG8_SA(0, 0), a2, voffA);
            PG8_WAIT_V(8); PG8_WAIT_L(0); PG8_BAR; PG8_MMA(1, 0, At, B0); PG8_MMA(1, 1, At, B1); PG8_BAR; PG8_SCHED;
            PG8_LDB(B0, 1, 0); PG8_LDB(B1, 1, 1); PG8_SCHED; PG8_LDA(At, 1, 0); PG8_STAGE(PG8_SA(0, 1), a2 + hstep, voffA);
            PG8_WAIT_V(8); PG8_WAIT_L(0); PG8_BAR; PG8_MMA(0, 0, At, B0); PG8_MMA(0, 1, At, B1); PG8_BAR; PG8_SCHED;
            PG8_LDA(At, 1, 1); PG8_STAGE(PG8_SB(1, 0), b3, voffB); PG8_STAGE(PG8_SB(1, 1), b3 + hstep, voffB); PG8_STAGE(PG8_SA(1, 0), a3, voffA);
            PG8_WAIT_V(8); PG8_WAIT_L(0); PG8_BAR; PG8_MMA(1, 0, At, B0); PG8_MMA(1, 1, At, B1); PG8_BAR; PG8_SCHED;
            } else {
            PG8_LDB(B0, 0, 0); PG8_SCHED; PG8_LDA(At, 0, 0); PG8_STAGE(PG8_SA(1, 1), a1 + hstep, voffA);
            PG8_WAIT_L(8); PG8_BAR; PG8_WAIT_L(0); PG8_MMA(0, 0, At, B0); PG8_BAR; PG8_SCHED;
            PG8_LDB(B1, 0, 1); PG8_STAGE(PG8_SB(0, 0), b2, voffB);
            PG8_BAR; PG8_WAIT_L(0); PG8_MMA(0, 1, At, B1); PG8_BAR;
            PG8_LDA(At, 0, 1); PG8_STAGE(PG8_SA(0, 0), a2, voffA);
            PG8_BAR; PG8_WAIT_L(0); PG8_MMA(1, 0, At, B0); PG8_BAR; PG8_SCHED;
            PG8_STAGE(PG8_SB(0, 1), b2 + hstep, voffB);
            PG8_WAIT_V(6); PG8_BAR; PG8_MMA(1, 1, At, B1); PG8_BAR;
            PG8_LDB(B0, 1, 0); PG8_SCHED; PG8_LDA(At, 1, 0); PG8_STAGE(PG8_SA(0, 1), a2 + hstep, voffA);
            PG8_WAIT_L(8); PG8_BAR; PG8_WAIT_L(0); PG8_MMA(0, 0, At, B0); PG8_BAR; PG8_SCHED;
            PG8_LDB(B1, 1, 1); PG8_STAGE(PG8_SB(1, 0), b3, voffB);
            PG8_BAR; PG8_WAIT_L(0); PG8_MMA(0, 1, At, B1); PG8_BAR;
            PG8_LDA(At, 1, 1); PG8_STAGE(PG8_SA(1, 0), a3, voffA);
            PG8_BAR; PG8_WAIT_L(0); PG8_MMA(1, 0, At, B0); PG8_BAR; PG8_SCHED;
            PG8_STAGE(PG8_SB(1, 1), b3 + hstep, voffB);
            PG8_WAIT_V(6); PG8_BAR; PG8_MMA(1, 1, At, B1); PG8_BAR;
            }
        }
        if constexpr (ALIGN_EPI) { if (wr == 0) PG8_BAR; }
        if constexpr (!Epi::AFTER_DRAIN) { E(acc, cur, wr, wc, fr, fq); S.done(cur); }
        if (!has_next) break;
#pragma unroll
        for (int a = 0; a < 2; ++a)
#pragma unroll
            for (int b = 0; b < 2; ++b)
#pragma unroll
                for (int m = 0; m < 4; ++m)
#pragma unroll
                    for (int n = 0; n < 2; ++n) acc[a][b][m][n] = (f32x4){0.f, 0.f, 0.f, 0.f};
        cur = nxt; cA = nA; cB = nB; ++ui; cnt = cur.nt ? cur.nt : nt;
        if constexpr (ALIGN_EPI) { if (wr == 1) PG8_BAR; }
    }
    PG8_WAIT_V(0);
    if constexpr (!ALIGN_EPI) { if (wr == 0) PG8_BAR; }
    PG8_BAR;
    if constexpr (Epi::AFTER_DRAIN) { E.fused(acc, cur, wr, wc, fr, fq, lds, wid, lane); S.done(cur); }
#undef PG8_SA
#undef PG8_SB
#undef PG8_STAGE
#undef PG8_LDA
#undef PG8_LDB
#undef PG8_MMA
#undef PG8_WAIT_V
#undef PG8_WAIT_L
#undef PG8_BAR
#undef PG8_SCHED
}
}
namespace att {
typedef unsigned short bf16_t;
using bf16x8 = __attribute__((ext_vector_type(8))) short;
using s16x4  = __attribute__((ext_vector_type(4))) short;
using f32x16 = __attribute__((ext_vector_type(16))) float;
using u32x4  = __attribute__((ext_vector_type(4))) unsigned;
constexpr int NW = 8, QBLK = 32, KVBLK = 64, LDX = 12800;
constexpr float THR = 8.f;
constexpr int SHM_V = KVBLK * 128 * 2, SHM_K = KVBLK * 128 * 2, SHM_ATTN = 2 * SHM_V + 2 * SHM_K + NW * 64 * 4;
#define ATT_SBAR() __builtin_amdgcn_sched_barrier(0)
__device__ __forceinline__ int crow(int r, int hi) { return (r & 3) + 8 * (r >> 2) + 4 * hi; }
__device__ __forceinline__ unsigned cvtpk(float lo, float hi) { unsigned r; asm volatile("v_cvt_pk_bf16_f32 %0, %1, %2" : "=v"(r) : "v"(lo), "v"(hi)); return r; }
template <int DQK> __device__ __forceinline__ int kswz(int row, int colB) {
  if constexpr (DQK == 128) return row * 256 + (colB ^ ((row & 7) << 4));
  else return (row >> 1) * 256 + ((((row & 1) << 7) + colB) ^ (((row >> 1) & 7) << 4));
}

__device__ __forceinline__ void partialSM(f32x16&) {}
__device__ __forceinline__ void finishSM(f32x16& p0, f32x16& p1, float& l_reg, bf16x8& pa0, bf16x8& pa1, bf16x8& pa2, bf16x8& pa3) {
#pragma unroll
  for (int r = 0; r < 16; ++r) p0[r] = __builtin_amdgcn_exp2f(p0[r]);
#pragma unroll
  for (int r = 0; r < 16; ++r) p1[r] = __builtin_amdgcn_exp2f(p1[r]);
  float ps = 0;
#pragma unroll
  for (int r = 0; r < 16; ++r) ps += p0[r];
#pragma unroll
  for (int r = 0; r < 16; ++r) ps += p1[r];
  l_reg += ps;
#define ATT_PK4(P, BASE, OUT) do { unsigned a0 = cvtpk(P[BASE + 0], P[BASE + 1]), a1 = cvtpk(P[BASE + 2], P[BASE + 3]);   \
    unsigned b0 = cvtpk(P[BASE + 4], P[BASE + 5]), b1 = cvtpk(P[BASE + 6], P[BASE + 7]);                              \
    auto r0 = __builtin_amdgcn_permlane32_swap(a0, b0, false, false); auto r1 = __builtin_amdgcn_permlane32_swap(a1, b1, false, false); \
    u32x4 w = {r0[0], r1[0], r0[1], r1[1]}; OUT = *reinterpret_cast<bf16x8*>(&w); } while (0)
  ATT_PK4(p0, 0, pa0); ATT_PK4(p0, 8, pa1); ATT_PK4(p1, 0, pa2); ATT_PK4(p1, 8, pa3);
#undef ATT_PK4
}
template <int DQK> __device__ __forceinline__ void qkt(f32x16& p0, f32x16& p1, const char* Ks, const bf16x8* qr, int r32, int hi) {
  constexpr int N = DQK / 16;
  bf16x8 k0[2], k1[2];
  { const int cb = (hi * 8) * 2; k0[0] = *reinterpret_cast<const bf16x8*>(Ks + kswz<DQK>(r32, cb)); k1[0] = *reinterpret_cast<const bf16x8*>(Ks + kswz<DQK>(32 + r32, cb)); }
  p0 = f32x16{}; p1 = f32x16{};
#pragma unroll
  for (int d0 = 0; d0 < N; ++d0) {
    if (d0 + 1 < N) { const int cb = ((d0 + 1) * 16 + hi * 8) * 2;
      k0[(d0 + 1) & 1] = *reinterpret_cast<const bf16x8*>(Ks + kswz<DQK>(r32, cb)); k1[(d0 + 1) & 1] = *reinterpret_cast<const bf16x8*>(Ks + kswz<DQK>(32 + r32, cb)); }
    __builtin_amdgcn_sched_barrier(0x406);
    p0 = __builtin_amdgcn_mfma_f32_32x32x16_bf16(k0[d0 & 1], qr[d0], p0, 0, 0, 0);
    p1 = __builtin_amdgcn_mfma_f32_32x32x16_bf16(k1[d0 & 1], qr[d0], p1, 0, 0, 0);
    __builtin_amdgcn_sched_barrier(0x406);
  }
}
__device__ __forceinline__ int v_st(int k, int c) { const int kk = (k & ~0xC) | ((k & 4) << 1) | ((k & 8) >> 1); return ((kk >> 3) * 4 + (c >> 5)) * 512 + ((kk & 7) * 32 + (c & 31)) * 2; }
__device__ __forceinline__ int v_rd_base(int lane) { return ((lane & 3) << 3) | (((lane >> 2) & 3) << 6) | (((lane >> 4) & 1) << 5) | (((lane >> 5) & 1) << 8); }
constexpr int v_rd_off(int d0, int ks, int half) { return d0 * 512 + ks * 4096 + half * 2048; }
template <int OFF> __device__ __forceinline__ s16x4 tr_read(int vb) {
  s16x4 r; asm volatile("ds_read_b64_tr_b16 %0, %1 offset:%2" : "=&v"(r) : "v"(vb), "i"(OFF) : "memory"); return r;
}
template <int D0> __device__ __forceinline__ void pv_one(f32x16& od, int vb, bf16x8 pa0, bf16x8 pa1, bf16x8 pa2, bf16x8 pa3) {
  const s16x4 l0 = tr_read<v_rd_off(D0, 0, 0)>(vb), h0 = tr_read<v_rd_off(D0, 0, 1)>(vb), l1 = tr_read<v_rd_off(D0, 1, 0)>(vb), h1 = tr_read<v_rd_off(D0, 1, 1)>(vb);
  const s16x4 l2 = tr_read<v_rd_off(D0, 2, 0)>(vb), h2 = tr_read<v_rd_off(D0, 2, 1)>(vb), l3 = tr_read<v_rd_off(D0, 3, 0)>(vb), h3 = tr_read<v_rd_off(D0, 3, 1)>(vb);
  asm volatile("s_waitcnt lgkmcnt(0)" ::: "memory"); ATT_SBAR();
#define ATT_PK(L, H) (bf16x8){L[0], L[1], L[2], L[3], H[0], H[1], H[2], H[3]}
  od = __builtin_amdgcn_mfma_f32_32x32x16_bf16(pa0, ATT_PK(l0, h0), od, 0, 0, 0);
  od = __builtin_amdgcn_mfma_f32_32x32x16_bf16(pa1, ATT_PK(l1, h1), od, 0, 0, 0);
  od = __builtin_amdgcn_mfma_f32_32x32x16_bf16(pa2, ATT_PK(l2, h2), od, 0, 0, 0);
  od = __builtin_amdgcn_mfma_f32_32x32x16_bf16(pa3, ATT_PK(l3, h3), od, 0, 0, 0);
#undef ATT_PK
}
__device__ __forceinline__ void pv_d0(f32x16* o, int vb, bf16x8 pa0, bf16x8 pa1, bf16x8 pa2, bf16x8 pa3) {
  pv_one<0>(o[0], vb, pa0, pa1, pa2, pa3); pv_one<1>(o[1], vb, pa0, pa1, pa2, pa3); pv_one<2>(o[2], vb, pa0, pa1, pa2, pa3); pv_one<3>(o[3], vb, pa0, pa1, pa2, pa3);
}

constexpr int SLOT = 32768, SLOT_V = 16384, NSLOT = 3, ATT_LDS = NSLOT * SLOT + NW * 64 * 4;
__device__ __forceinline__ void glds16(const void* sbase, unsigned voff, unsigned lds_dst) {
  unsigned keep;
  asm volatile("s_mov_b32 %0, m0\n\ts_mov_b32 m0, %3\n\ts_nop 0\n\tglobal_load_lds_dwordx4 %1, %2\n\ts_mov_b32 m0, %0" : "=&s"(keep) : "v"(voff), "s"(sbase), "s"(lds_dst) : "memory");
}
#define ATT_WAIT_BAR() asm volatile("s_waitcnt vmcnt(0) lgkmcnt(0)\n\ts_barrier" ::: "memory")
template <int DQK, bool OUTF32>
__device__ __forceinline__ void attn_body(const bf16_t* __restrict__ Qb, const bf16_t* __restrict__ Kh, const bf16_t* __restrict__ Vh,
                                          void* __restrict__ Ob, const int ldo, const int seq, char* lds, const int wid) {
  const int lane = opaque_lane(), r32 = lane & 31, hi = lane >> 5;
  const unsigned lds0 = (unsigned)(uintptr_t)lds;
  float* li_l = (float*)(lds + NSLOT * SLOT) + wid * 64;
  float l_reg = 0; f32x16 o[4] = {}; bf16x8 qr[DQK / 16];
  const bf16_t* Qw = Qb + (long)(wid * QBLK + r32) * LDX + hi * 8;
#pragma unroll
  for (int d0 = 0; d0 < DQK / 16; ++d0) qr[d0] = *reinterpret_cast<const bf16x8*>(Qw + d0 * 16);
  unsigned offK[2], offV[2];
  if constexpr (DQK == 128) {
#pragma unroll
    for (int i = 0; i < 2; ++i) { const int row = 4 * (2 * wid + i) + (lane >> 4), colB = ((lane & 15) * 16) ^ ((row & 7) << 4); offK[i] = (unsigned)(row * (LDX * 2) + colB); }
  } else {
    const int sr = 4 * wid + (lane >> 4), x = ((lane & 15) * 16) ^ ((sr & 7) << 4), row = 2 * sr + (x >> 7); offK[0] = (unsigned)(row * (LDX * 2) + (x & 127)); offK[1] = 0;
  }
#pragma unroll
  for (int i = 0; i < 2; ++i) { const int sub = 2 * (2 * wid + i) + (lane >> 5), kk = (sub >> 2) * 8 + ((lane & 31) >> 2), c = (sub & 3) * 32 + (lane & 3) * 8;
    const int k = (kk & ~0xC) | ((kk & 4) << 1) | ((kk & 8) >> 1); offV[i] = (unsigned)(k * (LDX * 2) + c * 2); }
  const unsigned dstK = lds0 + (DQK == 128 ? 2 * wid : wid) * 1024, dstV = lds0 + SLOT_V + 2 * wid * 1024;
#define ATT_DMA(t, slotoff) do { const char* kb_ = (const char*)Kh + (size_t)(t) * (KVBLK * LDX * 2); const char* vb_ = (const char*)Vh + (size_t)(t) * (KVBLK * LDX * 2); \
    glds16(kb_, offK[0], dstK + (slotoff)); if constexpr (DQK == 128) glds16(kb_, offK[1], dstK + (slotoff) + 1024); \
    glds16(vb_, offV[0], dstV + (slotoff)); glds16(vb_, offV[1], dstV + (slotoff) + 1024); } while (0)
#define ATT_NEXT(so) ((so) == 2 * SLOT ? 0 : (so) + SLOT)
  const int vb0 = (int)lds0 + SLOT_V + v_rd_base(lane);
  f32x16 pA0, pA1, pB0, pB1; bf16x8 pa0, pa1, pa2, pa3; const int NT = seq / KVBLK;
  ATT_DMA(0, 0); ATT_DMA(1, SLOT);
  if constexpr (DQK == 128) asm volatile("s_waitcnt vmcnt(4)\n\ts_barrier" ::: "memory"); else asm volatile("s_waitcnt vmcnt(3)\n\ts_barrier" ::: "memory");
  qkt<DQK>(pA0, pA1, lds, qr, r32, hi); partialSM(pA0);
  ATT_WAIT_BAR();
  int so_p = 0, so_c = SLOT, so_n = 2 * SLOT;
  for (int j = 1; j + 1 < NT; j += 2) {
    ATT_SBAR(); qkt<DQK>(pB0, pB1, lds + so_c, qr, r32, hi);
    if (j + 1 < NT) ATT_DMA(j + 1, so_n);
    finishSM(pA0, pA1, l_reg, pa0, pa1, pa2, pa3); ATT_SBAR();
    pv_d0(o, vb0 + so_p, pa0, pa1, pa2, pa3); partialSM(pB0);
    ATT_WAIT_BAR();
    so_p = so_c; so_c = ATT_NEXT(so_c); so_n = ATT_NEXT(so_n);
    ATT_SBAR(); qkt<DQK>(pA0, pA1, lds + so_c, qr, r32, hi);
    if (j + 2 < NT) ATT_DMA(j + 2, so_n);
    finishSM(pB0, pB1, l_reg, pa0, pa1, pa2, pa3); ATT_SBAR();
    pv_d0(o, vb0 + so_p, pa0, pa1, pa2, pa3); partialSM(pA0);
    ATT_WAIT_BAR();
    so_p = so_c; so_c = ATT_NEXT(so_c); so_n = ATT_NEXT(so_n);
  }
  ATT_SBAR(); qkt<DQK>(pB0, pB1, lds + so_c, qr, r32, hi);
  finishSM(pA0, pA1, l_reg, pa0, pa1, pa2, pa3); ATT_SBAR();
  pv_d0(o, vb0 + so_p, pa0, pa1, pa2, pa3); partialSM(pB0);
  finishSM(pB0, pB1, l_reg, pa0, pa1, pa2, pa3); ATT_SBAR();
  pv_d0(o, vb0 + so_c, pa0, pa1, pa2, pa3);
  { auto rr = __builtin_amdgcn_permlane32_swap(__float_as_uint(l_reg), __float_as_uint(l_reg), false, false); l_reg = __uint_as_float(rr[0]) + __uint_as_float(rr[1]); }
  if (hi == 0) li_l[r32] = l_reg; asm volatile("s_waitcnt lgkmcnt(0)" ::: "memory");
  float rli[16];
#pragma unroll
  for (int r = 0; r < 16; ++r) rli[r] = __builtin_amdgcn_rcpf(li_l[crow(r, hi)]);
  if constexpr (OUTF32) {
    bf16_t* Ow = (bf16_t*)Ob + (long)(wid * QBLK) * ldo;
    const bool odd = (r32 & 1) != 0;
#pragma unroll
    for (int r = 0; r < 16; r += 2) { const int orow = crow(r, hi) + (odd ? 1 : 0);
#pragma unroll
      for (int d0 = 0; d0 < 4; ++d0) { const float xa = o[d0][r] * rli[r], xb = o[d0][r + 1] * rli[r + 1];
        const float send = odd ? xa : xb, keep = odd ? xb : xa;
        const float recv = __int_as_float(__builtin_amdgcn_mov_dpp(__float_as_int(send), 0xB1, 0xf, 0xf, true));
        const unsigned w = pg8::cvt_pk_bf16(odd ? recv : keep, odd ? keep : recv);
        *(unsigned*)(Ow + (long)orow * ldo + d0 * 32 + (r32 & ~1)) = w; } }
  } else {
    bf16_t* Ow = (bf16_t*)Ob + (long)(wid * QBLK) * ldo;
#pragma unroll
    for (int r = 0; r < 16; ++r) { const int orow = crow(r, hi);
#pragma unroll
      for (int d0 = 0; d0 < 4; ++d0) Ow[(long)orow * ldo + d0 * 32 + r32] = (bf16_t)(cvtpk(o[d0][r] * rli[r], 0.f) & 0xffffu); }
  }
#undef ATT_DMA
#undef ATT_NEXT
}
}
constexpr int NWAVES = 8, NTHR = 512;
constexpr int DM = 4096, NB = 2, SEQ = 8192, CTX = 256, DEPTH = 2, DFF = 11008, INC = 12800;
constexpr int ROWS_B = 8448, MROWS = NB * ROWS_B, NCHUNK = MROWS / 16;
constexpr int C_AQ = 0, C_CQ = 1536, C_BQ = 2816, C_BG = 4096, C_AK = 5376, C_AV = 5888, C_CK = 6400, C_CV = 7680, C_BI = 8960, C_BFF = 10240, C_BFB = 11520;
constexpr int BW = 1280;
constexpr float EPS = 1e-6f;
#ifndef DBL
#define DBL 0
#endif
#define WGM_IN 4
#define WGM_OUT 4
#define WGM_GU 4
#define WGM_DN 4
#ifndef MK_ONE_LAUNCH
#define MK_ONE_LAUNCH 1
#endif
constexpr int N_PHASES = 2 + 9 * DEPTH;

constexpr size_t MiB = 1u << 20;
constexpr size_t al256(size_t x) { return (x + 255) / 256 * 256; }
constexpr size_t WS_CTL = 0, CTL_ZERO_BYTES = 1 * MiB;
constexpr size_t SZ_WIN = (size_t)INC * DM * 2, SZ_WOUT = (size_t)DM * DM * 2, SZ_WGU = (size_t)2 * DFF * DM * 2, SZ_WDN = (size_t)DM * DFF * 2;
constexpr size_t WS_WIN = 1 * MiB, WS_WOUT = WS_WIN + DEPTH * SZ_WIN, WS_WGU = WS_WOUT + DEPTH * SZ_WOUT, WS_WDN = WS_WGU + DEPTH * SZ_WGU;
constexpr size_t WS_MODP = WS_WDN + DEPTH * SZ_WDN;
constexpr size_t WS_MOD = WS_MODP + (size_t)16 * 2 * 3 * 24576 * 4;
constexpr size_t WS_XRES = al256(WS_MOD + (size_t)2 * 3 * 24576 * 4);
constexpr size_t WS_HX = WS_XRES + (size_t)MROWS * DM * 4;
constexpr size_t WS_QKV = WS_HX + (size_t)MROWS * DM * 2;
constexpr size_t WS_MIX = WS_QKV + (size_t)MROWS * INC * 2;
constexpr size_t WS_OC = WS_MIX + (size_t)MROWS * DM * 2;
constexpr size_t SZ_SC = (size_t)MROWS * BW * 2;
constexpr size_t WS_QT = WS_OC + (size_t)MROWS * 2560 * 4;
constexpr size_t WS_KT = WS_QT + 2 * SZ_SC, WS_KP = WS_KT + 2 * SZ_SC, WS_VT = WS_KP + 2 * SZ_SC;
constexpr size_t WS_DEC = WS_VT + SZ_SC;
constexpr size_t WS_OB = WS_DEC + (size_t)2 * NCHUNK * BW * 4;
constexpr size_t WS_PART = WS_OB + (size_t)2 * MROWS * BW * 4;
constexpr size_t WS_END = WS_PART + (size_t)8 * 512 * DM * 4;
constexpr int CW_TMO = 0, CW_BAR = 4096, CW_WQ = 8192;

constexpr int RING_BYTES = 131072, MISC_OFF = RING_BYTES + 320, LDS_BYTES = 147456;

#define GAS __attribute__((address_space(1)))
#define LAS __attribute__((address_space(3)))
typedef unsigned short bf16;
typedef unsigned v4u __attribute__((ext_vector_type(4)));
typedef unsigned v2u __attribute__((ext_vector_type(2)));
typedef float f32x4 __attribute__((ext_vector_type(4)));
typedef float f32x2 __attribute__((ext_vector_type(2)));
typedef short bf16x8 __attribute__((ext_vector_type(8)));
typedef short s16x4 __attribute__((ext_vector_type(4)));
typedef GAS unsigned gu32;
#define RLX_AGENT __ATOMIC_RELAXED, __HIP_MEMORY_SCOPE_AGENT
#define LDS_WAIT() asm volatile("s_waitcnt lgkmcnt(0)" ::: "memory")
typedef __bf16 bf16x2_t __attribute__((ext_vector_type(2)));
__device__ __forceinline__ unsigned pkbf(float lo, float hi) { f32x2 v = {lo, hi}; bf16x2_t b = __builtin_convertvector(v, bf16x2_t); return __builtin_bit_cast(unsigned, b); }
__device__ __forceinline__ float bf2f(unsigned short h) { return __uint_as_float((unsigned)h << 16); }
__device__ __forceinline__ float bflo(unsigned w) { return __uint_as_float(w << 16); }
__device__ __forceinline__ float bfhi(unsigned w) { return __uint_as_float(w & 0xffff0000u); }
template <int M> __device__ __forceinline__ float swz_xor(float v) { return __int_as_float(__builtin_amdgcn_ds_swizzle(__float_as_int(v), 0x1f | (M << 10))); }
__device__ __forceinline__ float half_sum(float v) {
    v += swz_xor<1>(v); v += swz_xor<2>(v); v += swz_xor<4>(v); v += swz_xor<8>(v); v += swz_xor<16>(v);
    return v;
}
__device__ __forceinline__ float wave_sum(float v) {
    v = half_sum(v);
    auto rr = __builtin_amdgcn_permlane32_swap(__float_as_uint(v), __float_as_uint(v), false, false);
    return __uint_as_float(rr[0]) + __uint_as_float(rr[1]);
}
__device__ __forceinline__ float bcast_lane(float v, int j) { return __int_as_float(__builtin_amdgcn_readlane(__float_as_int(v), j)); }
__device__ __forceinline__ float silu_f(float x) { return x * __builtin_amdgcn_rcpf(1.0f + __expf(-x)); }
#define XB_TMO      128
#define XB_XCNT(j)  (256  + 64 * (j))
#define XB_XSUB(j)  (1280 + 64 * (j))
#define XB_XGEN(j)  (2304 + 64 * (j))
#define XB_TOP      3328
#define XB_TOPGEN   3392
#define XCD_BAR_WORDS 3456
#define XB_SPIN_CAP (1u << 18)

__device__ __forceinline__ unsigned xb_ld(unsigned* p)              { return __hip_atomic_load(p, __ATOMIC_RELAXED, __HIP_MEMORY_SCOPE_AGENT); }
__device__ __forceinline__ unsigned xb_add(unsigned* p, unsigned v) { return __hip_atomic_fetch_add(p, v, __ATOMIC_RELAXED, __HIP_MEMORY_SCOPE_AGENT); }
__device__ __forceinline__ unsigned xb_xcc_id() { return (unsigned)__builtin_amdgcn_s_getreg((3 << 11) | 20) & 0xFu; }
#define XB_SPIN(cond, bar) do { unsigned _sp = 0; while (cond) { __builtin_amdgcn_s_sleep(1); \
    if ((++_sp & 255u) == 0u) { if (xb_ld(&(bar)[XB_TMO])) break; if (_sp > XB_SPIN_CAP) { atomicAdd(&(bar)[XB_TMO], 1u); break; } } } } while (0)

struct XcdBarrier {
    unsigned* bar; unsigned x;
    volatile LAS unsigned* st;
};

__device__ __forceinline__ XcdBarrier xcd_barrier_post(unsigned* bar, volatile LAS unsigned* st) {
    XcdBarrier b; b.bar = bar; b.x = xb_xcc_id(); b.st = st;
    if (threadIdx.x == 0) (void)xb_add(&bar[XB_XCNT(b.x)], 1u);
    return b;
}
__device__ __forceinline__ void xcd_barrier_complete(unsigned* bar, unsigned x, unsigned& nloc, unsigned& nx) {
    const unsigned G = gridDim.x * gridDim.y * gridDim.z;
    unsigned sum, cnt, mine, sp = 0u;
    for (;;) {
        sum = 0u; cnt = 0u; mine = 0u;
#pragma unroll
        for (unsigned j = 0; j < 16; ++j) { const unsigned c = xb_ld(&bar[XB_XCNT(j)]); sum += c; cnt += (c > 0u) ? 1u : 0u; mine = (j == x) ? c : mine; }
        if (sum == G) break;
        __builtin_amdgcn_s_sleep(1);
        if ((++sp & 255u) == 0u) { if (xb_ld(&bar[XB_TMO])) break; if (sp > XB_SPIN_CAP) { atomicAdd(&bar[XB_TMO], 1u); break; } }
    }
    nloc = mine > 0u ? mine : 1u; nx = cnt > 0u ? cnt : 1u;
}

__device__ __forceinline__ void xcd_barrier(const XcdBarrier& b) {
    asm volatile("s_waitcnt vmcnt(0)" ::: "memory");
    __syncthreads();
    if (threadIdx.x == 0) {
        unsigned* bar = b.bar;
        __builtin_amdgcn_s_waitcnt(0);
        unsigned nloc = b.st[0], nx = b.st[1];
        if (nloc == 0u) { xcd_barrier_complete(bar, b.x, nloc, nx); b.st[0] = nloc; b.st[1] = nx; }
        const unsigned old = xb_add(&bar[XB_XSUB(b.x)], 1u);
        const unsigned gen = old / nloc;
        if (old + 1u == (gen + 1u) * nloc) {
            __builtin_amdgcn_fence(__ATOMIC_RELEASE, "agent");
            asm volatile("s_waitcnt vmcnt(0)" ::: "memory");
            const unsigned og = xb_add(&bar[XB_TOP], 1u);
            const unsigned tg = og / nx;
            if (og + 1u == (tg + 1u) * nx) xb_add(&bar[XB_TOPGEN], 1u);
            else XB_SPIN(xb_ld(&bar[XB_TOPGEN]) == tg, bar);
            __builtin_amdgcn_fence(__ATOMIC_ACQUIRE, "agent");
            xb_add(&bar[XB_XGEN(b.x)], 1u);
            asm volatile("s_waitcnt vmcnt(0)" ::: "memory");
        } else {
            XB_SPIN(xb_ld(&bar[XB_XGEN(b.x)]) == gen, bar);
            __builtin_amdgcn_fence(__ATOMIC_ACQUIRE, "agent");
            asm volatile("s_waitcnt vmcnt(0)" ::: "memory");
        }
    }
    __syncthreads();
}
struct Args { const float* in[19]; float* out; unsigned char* ws; int ph_lo, ph_hi; };
typedef const Args __attribute__((address_space(4)))* KArgs;
__device__ __forceinline__ KArgs fresh_args() { KArgs p = (KArgs)__builtin_amdgcn_kernarg_segment_ptr(); asm volatile("" : "+s"(p)); return p; }
constexpr int I_IN = 64 * 400, I_OUT = 64 * 128, I_G = 64 * 344, I_DN = 172 * 128, I_LAYER = I_IN + I_OUT + 2 * I_G + I_DN;
constexpr int CONV_PER_WAVE = 12, CONV_UNIT = 8 * CONV_PER_WAVE, N_CONV_UNITS = (DEPTH * I_LAYER - I_IN + CONV_UNIT - 1) / CONV_UNIT;
struct ConvItem { const float* src; bf16* dst; int N, pitch; };
__device__ __forceinline__ ConvItem conv_decode(KArgs P, int it, int lane) {
    const int l = it / I_LAYER; int r = it % I_LAYER; const float* W; bf16* WT; int N, pitch, k0, n0, drow;
    if (r < I_IN) { const int kb = r / 400, nb = r % 400; W = P->in[6] + (size_t)l * DM * INC; N = INC; WT = (bf16*)(P->ws + WS_WIN + l * SZ_WIN); pitch = DM; k0 = 64 * kb; n0 = 32 * nb; drow = n0; }
    else if ((r -= I_IN) < I_OUT) { const int kb = r / 128, nb = r % 128; W = P->in[7] + (size_t)l * DM * DM; N = DM; WT = (bf16*)(P->ws + WS_WOUT + l * SZ_WOUT); pitch = DM; k0 = 64 * kb; n0 = 32 * nb; drow = n0; }
    else if ((r -= I_OUT) < 2 * I_G) { const int up = r >= I_G; if (up) r -= I_G; const int kb = r / 344, nb = r % 344; n0 = 32 * nb;
        W = (up ? P->in[17] : P->in[16]) + (size_t)l * DM * DFF; N = DFF; WT = (bf16*)(P->ws + WS_WGU + l * SZ_WGU); pitch = DM; k0 = 64 * kb; drow = (n0 >> 7) * 256 + (n0 & 127) + (up ? 128 : 0); }
    else { r -= 2 * I_G; const int kb = r / 128, nb = r % 128; W = P->in[18] + (size_t)l * DFF * DM; N = DM; WT = (bf16*)(P->ws + WS_WDN + l * SZ_WDN); pitch = DFF; k0 = 64 * kb; n0 = 32 * nb; drow = n0; }
    ConvItem c; c.src = W + (size_t)(k0 + (lane >> 5)) * N + n0 + (lane & 31); c.dst = WT + (size_t)drow * pitch + k0; c.N = N; c.pitch = pitch; return c;
}
__device__ __forceinline__ void conv_load(float (&v)[32], const ConvItem& c) {
#pragma unroll
    for (int i = 0; i < 32; ++i) v[i] = __builtin_nontemporal_load(c.src + (size_t)(2 * i) * c.N);
}
__device__ __forceinline__ void conv_finish(const float (&v)[32], const ConvItem& c, LAS float* scr, int lane) {
#pragma unroll
    for (int i = 0; i < 32; ++i) scr[(2 * i + (lane >> 5)) * 33 + (lane & 31)] = v[i];
    LDS_WAIT(); asm volatile("" ::: "memory");
    const int cc = lane & 7;
#pragma unroll
    for (int j = 0; j < 4; ++j) { const int n = (lane >> 3) + 8 * j; const LAS float* s = scr + (8 * cc) * 33 + n;
        v4u o; o.x = pkbf(s[0 * 33], s[1 * 33]); o.y = pkbf(s[2 * 33], s[3 * 33]); o.z = pkbf(s[4 * 33], s[5 * 33]); o.w = pkbf(s[6 * 33], s[7 * 33]);
        __builtin_nontemporal_store(o, (GAS v4u*)(c.dst + (size_t)n * c.pitch + 8 * cc)); }
    LDS_WAIT(); asm volatile("" ::: "memory");
}
template <int NI> __device__ __forceinline__ void conv_run(KArgs P, int it0, int stride, int last, LAS float* scr, int lane) {
    float va[32], vb[32];
#define CONV_IT(k) (it0 + (k) * stride < last ? it0 + (k) * stride : last)
    ConvItem ca = conv_decode(P, CONV_IT(0), lane), cb = ca; conv_load(va, ca);
#pragma unroll 1
    for (int k = 0; k + 2 < NI; k += 2) {
        cb = conv_decode(P, CONV_IT(k + 1), lane); conv_load(vb, cb);
        conv_finish(va, ca, scr, lane);
        ca = conv_decode(P, CONV_IT(k + 2), lane); conv_load(va, ca);
        conv_finish(vb, cb, scr, lane);
    }
    if constexpr (NI % 2 == 0) { cb = conv_decode(P, CONV_IT(NI - 1), lane); conv_load(vb, cb); conv_finish(va, ca, scr, lane); conv_finish(vb, cb, scr, lane); }
    else conv_finish(va, ca, scr, lane);
#undef CONV_IT
}
__device__ __forceinline__ void p0_prologue(KArgs P, LAS unsigned char* lds, int gw, int NGW, int wave, int lane) {
    LAS float* scr = (LAS float*)(lds + wave * 16384);
    conv_run<13>(P, gw, NGW, I_IN - 1, scr, lane);
    for (int it = gw + 13 * NGW; it < I_IN; it += NGW) conv_run<1>(P, it, NGW, I_IN - 1, scr, lane);
    float* modp = (float*)(P->ws + WS_MODP);
    for (int it = gw; it < 2 * 96 * 16; it += NGW) {
        const int kp = it & 15, cb = (it >> 4) % 96, l = it / (16 * 96);
        f32x4 a0 = {0.f, 0.f, 0.f, 0.f}, a1 = a0, a2 = a0;
        const float* wb = P->in[4] + ((size_t)l * DM + 256 * kp) * 24576 + 256 * cb + 4 * lane;
        for (int kb = 0; kb < 4; ++kb) {
            const int k0 = 256 * kp + 64 * kb;
            const float s0 = silu_f(P->in[1][k0 + lane]), s1 = silu_f(P->in[1][DM + k0 + lane]), s2 = silu_f(P->in[3][k0 + lane]);
#pragma unroll 8
            for (int j = 0; j < 64; ++j) {
                const f32x4 w = *(const f32x4*)(wb + (size_t)(64 * kb + j) * 24576);
                a0 += w * bcast_lane(s0, j); a1 += w * bcast_lane(s1, j); a2 += w * bcast_lane(s2, j);
            }
        }
        float* o = modp + ((size_t)(kp * 2 + l) * 3) * 24576 + 256 * cb + 4 * lane;
        *(f32x4*)(o) = a0; *(f32x4*)(o + 24576) = a1; *(f32x4*)(o + 2 * 24576) = a2;
    }
}
__device__ __forceinline__ void p1_modreduce(KArgs P, int gtid, int NGT) {
    const float* modp = (const float*)(P->ws + WS_MODP); float* mod = (float*)(P->ws + WS_MOD);
    for (int i = gtid; i < 2 * 3 * 24576; i += NGT) {
        const int n = i % 24576, l = i / (3 * 24576);
        float s = P->in[5][l * 24576 + n];
#pragma unroll
        for (int kp = 0; kp < 16; ++kp) s += modp[(size_t)kp * (2 * 3 * 24576) + i];
        mod[i] = s;
    }
}
__device__ __forceinline__ void norm_phase(KArgs P, int l, int shift_idx, int scale_idx, int from_in, int skip_ctx, int add_parts, int gw, int ngw, int lane) {
    const bf16* xres = (const bf16*)(P->ws + WS_XRES); bf16* hx = (bf16*)(P->ws + WS_HX);
    const float* modl = (const float*)(P->ws + WS_MOD) + (size_t)l * 3 * 24576;
    auto load_row = [&](int row, f32x4 (&v)[16]) {
        const int b = row / ROWS_B, j = row % ROWS_B;
        if (from_in) { const float* src = (j < CTX) ? P->in[2] + ((size_t)b * CTX + j) * DM : P->in[0] + ((size_t)b * SEQ + (j - CTX)) * DM;
            const f32x4* xr = (const f32x4*)src + lane;
#pragma unroll
            for (int q = 0; q < 16; ++q) v[q] = xr[64 * q]; }
        else { const v2u* xb = (const v2u*)(xres + (size_t)row * DM) + lane;
#pragma unroll
            for (int q = 0; q < 16; ++q) { const v2u t = xb[64 * q]; v[q] = (f32x4){__uint_as_float(t.x << 16), __uint_as_float(t.x & 0xffff0000u), __uint_as_float(t.y << 16), __uint_as_float(t.y & 0xffff0000u)}; } }
    };
    auto finish_row = [&](int row, f32x4 (&v)[16]) {
        const int b = row / ROWS_B, j = row % ROWS_B, rsel = (j < CTX) ? 2 : b;
        const f32x4* sh = (const f32x4*)(modl + rsel * 24576 + shift_idx * DM) + lane;
        const f32x4* sc = (const f32x4*)(modl + rsel * 24576 + scale_idx * DM) + lane;
        float ss = 0.f;
#pragma unroll
        for (int q = 0; q < 16; ++q) ss += (v[q].x * v[q].x + v[q].y * v[q].y) + (v[q].z * v[q].z + v[q].w * v[q].w);
        if (add_parts && j < CTX) {
            const f32x4* pp = (const f32x4*)(P->ws + WS_PART + ((size_t)(b * 256 + j) * DM) * 4) + lane; ss = 0.f;
#pragma unroll
            for (int q = 0; q < 16; ++q) { f32x4 t[8];
#pragma unroll
                for (int sl = 0; sl < 8; ++sl) t[sl] = pp[(size_t)sl * 512 * DM / 4 + 64 * q];
                f32x4 a = v[q];
#pragma unroll
                for (int sl = 0; sl < 8; ++sl) a += t[sl];
                v[q] = a; ss += (a.x * a.x + a.y * a.y) + (a.z * a.z + a.w * a.w); } }
        if ((from_in || add_parts) && j < CTX) { v2u* xo = (v2u*)(P->ws + WS_XRES + (size_t)row * DM * 2) + lane;
#pragma unroll
            for (int q = 0; q < 16; ++q) { v2u w; w.x = pkbf(v[q].x, v[q].y); w.y = pkbf(v[q].z, v[q].w); xo[64 * q] = w; } }
        const float rstd = __builtin_amdgcn_rsqf(wave_sum(ss) * (1.f / DM) + EPS);
        v2u* o = (v2u*)(hx + (size_t)row * DM) + lane;
#pragma unroll
        for (int q = 0; q < 16; ++q) { const f32x4 s1 = sc[64 * q], s0 = sh[64 * q]; const f32x4 y = v[q] * rstd * (s1 + 1.0f) + s0;
            v2u w; w.x = pkbf(y.x, y.y); w.y = pkbf(y.z, y.w); o[64 * q] = w; }
    };
    for (int row = gw; row < MROWS; row += 2 * ngw) {
        const int rowB = row + ngw;
        const bool okA = !(skip_ctx && (row % ROWS_B) < CTX), okB = rowB < MROWS && !(skip_ctx && (rowB % ROWS_B) < CTX);
        f32x4 va[16], vb[16];
        if (okA) load_row(row, va);
        if (okB) load_row(rowB, vb);
        if (okA) finish_row(row, va);
        if (okB) finish_row(rowB, vb);
    }
}
__device__ __forceinline__ void scanprep_phase(KArgs P, int l, int gtid, int NGT) {
    const bf16* qkv = (const bf16*)(P->ws + WS_QKV);
    bf16* QT = (bf16*)(P->ws + WS_QT); bf16* KT = (bf16*)(P->ws + WS_KT); bf16* KP = (bf16*)(P->ws + WS_KP); bf16* VT = (bf16*)(P->ws + WS_VT);
    float* DEC = (float*)(P->ws + WS_DEC);
    for (int idx = gtid; idx < NCHUNK * BW; idx += NGT) {
        const int ch = idx / BW, hd = idx % BW;
        float lbf = 0.f, lbb = 0.f;
        if (l > 0) { lbf = 1.f / (1.f + __expf(P->in[10][0 * 2 * BW + 0 * BW + hd] - P->in[10][1 * 2 * BW + 0 * BW + hd]));
                     lbb = 1.f / (1.f + __expf(P->in[10][0 * 2 * BW + 1 * BW + hd] - P->in[10][1 * 2 * BW + 1 * BW + hd])); }
        const bf16* base = qkv + (size_t)(ch * 16) * INC + hd;
        float q[16], gf[16], of[16], gb[16], ob[16]; unsigned short vv[16];
#pragma unroll
        for (int t = 0; t < 16; ++t) {
            const bf16* rp = base + (size_t)t * INC;
            q[t] = silu_f(bf2f(rp[C_BQ])); vv[t] = rp[C_BI];
            const float zf = bf2f(rp[C_BFF]), zb = bf2f(rp[C_BFB]);
            const float ef = __expf(-zf), sf = __builtin_amdgcn_rcpf(1.f + ef); gf[t] = __logf(lbf + (1.f - lbf) * sf); of[t] = (1.f - lbf) * ef * sf;
            const float eb = __expf(-zb), sb = __builtin_amdgcn_rcpf(1.f + eb); gb[t] = __logf(lbb + (1.f - lbb) * sb); ob[t] = (1.f - lbb) * eb * sb;
        }
        const int dl = hd & 31, pos = (hd & ~31) + 8 * ((dl >> 2) & 3) + 4 * (dl >> 4) + (dl & 3);
        { float b = 0.f; float bt[16];
#pragma unroll
          for (int t = 0; t < 16; ++t) { b += gf[t]; bt[t] = b; }
          unsigned kp[8];
#pragma unroll
          for (int t = 0; t < 16; ++t) { const float e = __expf(bt[t]);
              QT[(size_t)(ch * 16 + t) * BW + pos] = (bf16)(pkbf(q[t] * e, 0.f) & 0xffffu);
              KT[(size_t)(ch * 16 + t) * BW + pos] = (bf16)(pkbf(of[t] * __expf(-bt[t]), 0.f) & 0xffffu); }
#pragma unroll
          for (int t = 0; t < 16; t += 2) kp[t >> 1] = pkbf(of[t] * __expf(b - bt[t]), of[t + 1] * __expf(b - bt[t + 1]));
          v4u* o = (v4u*)(KP + ((size_t)ch * BW + hd) * 16); o[0] = (v4u){kp[0], kp[1], kp[2], kp[3]}; o[1] = (v4u){kp[4], kp[5], kp[6], kp[7]};
          DEC[(size_t)ch * BW + hd] = __expf(b); }
        { float b = 0.f; float bt[16];
#pragma unroll
          for (int t = 15; t >= 0; --t) { b += gb[t]; bt[t] = b; }
          unsigned kp[8];
          bf16* QTb = QT + (size_t)MROWS * BW; bf16* KTb = KT + (size_t)MROWS * BW;
#pragma unroll
          for (int t = 0; t < 16; ++t) { const float e = __expf(bt[t]);
              QTb[(size_t)(ch * 16 + t) * BW + pos] = (bf16)(pkbf(q[t] * e, 0.f) & 0xffffu);
              KTb[(size_t)(ch * 16 + t) * BW + pos] = (bf16)(pkbf(ob[t] * __expf(-bt[t]), 0.f) & 0xffffu); }
#pragma unroll
          for (int t = 0; t < 16; t += 2) kp[t >> 1] = pkbf(ob[t] * __expf(b - bt[t]), ob[t + 1] * __expf(b - bt[t + 1]));
          v4u* o = (v4u*)(KP + (size_t)MROWS * BW + ((size_t)ch * BW + hd) * 16); o[0] = (v4u){kp[0], kp[1], kp[2], kp[3]}; o[1] = (v4u){kp[4], kp[5], kp[6], kp[7]};
          DEC[(size_t)NCHUNK * BW + (size_t)ch * BW + hd] = __expf(b); }
        { v4u* o = (v4u*)(VT + ((size_t)ch * BW + hd) * 16);
          o[0] = (v4u){vv[0] | ((unsigned)vv[1] << 16), vv[2] | ((unsigned)vv[3] << 16), vv[4] | ((unsigned)vv[5] << 16), vv[6] | ((unsigned)vv[7] << 16)};
          o[1] = (v4u){vv[8] | ((unsigned)vv[9] << 16), vv[10] | ((unsigned)vv[11] << 16), vv[12] | ((unsigned)vv[13] << 16), vv[14] | ((unsigned)vv[15] << 16)}; }
    }
}
constexpr int SC_SLOT = 17408, SC_NSLOT = 4;
__device__ __forceinline__ void sc_glds16(const void* sbase, unsigned voff, unsigned lds_dst) { unsigned keep;
  asm volatile("s_mov_b32 %0, m0\n\ts_mov_b32 m0, %3\n\ts_nop 0\n\tglobal_load_lds_dwordx4 %1, %2\n\ts_mov_b32 m0, %0" : "=&s"(keep) : "v"(voff), "s"(sbase), "s"(lds_dst) : "memory"); }
__device__ __forceinline__ void sc_glds4(const void* sbase, unsigned voff, unsigned lds_dst) { unsigned keep;
  asm volatile("s_mov_b32 %0, m0\n\ts_mov_b32 m0, %3\n\ts_nop 0\n\tglobal_load_lds_dword %1, %2\n\ts_mov_b32 m0, %0" : "=&s"(keep) : "v"(voff), "s"(sbase), "s"(lds_dst) : "memory"); }
__device__ __forceinline__ void scan_unit(KArgs P, int chain, int wave, LAS unsigned char* ldsl) {
    const int lane = opaque_lane();
    const int b = chain / 20, h = (chain >> 1) % 10, dir = chain & 1;
    bf16* OB = (bf16*)(P->ws + WS_OB) + (size_t)dir * MROWS * BW;
    const int l16 = lane & 15, g = lane >> 4;
    const unsigned lds0 = (unsigned)(uintptr_t)ldsl;
    const int kind = wave >> 1, half = wave & 1;
    const char* src = (const char*)(P->ws + (kind == 0 ? WS_QT : kind == 1 ? WS_KT : kind == 2 ? WS_KP : WS_VT)) + (kind == 3 ? (size_t)0 : (size_t)dir * SZ_SC) + (kind < 2 ? h * 256 : h * 4096);
    unsigned voff[2];
#pragma unroll
    for (int i = 0; i < 2; ++i) { const int pr = 2 * half + i;
        if (kind < 2) { const int row = 4 * pr + (lane >> 4), logical = (lane & 15) ^ row; voff[i] = (unsigned)(row * (BW * 2) + logical * 16); }
        else voff[i] = (unsigned)(pr * 1024 + lane * 16); }
    const unsigned dst = lds0 + kind * 4096 + 2 * half * 1024, dstdec = lds0 + 16384 + half * 256;
    const char* srcdec = (const char*)(P->ws + WS_DEC) + ((size_t)dir * NCHUNK * BW + h * 128) * 4 + half * 256;
#define SC_CHUNK(ci) (b * 528 + (dir ? ((ci) < 16 ? 15 - (ci) : 543 - (ci)) : (ci)))
#define SC_DMA(ci, so) do { const int ch_ = SC_CHUNK(ci); const char* s_ = src + (size_t)ch_ * 40960; \
        sc_glds16(s_, voff[0], dst + (so)); sc_glds16(s_, voff[1], dst + (so) + 1024); sc_glds4(srcdec + (size_t)ch_ * 5120, (unsigned)lane * 4u, dstdec + (so)); } while (0)
#define SC_NEXT(so) ((so) == (SC_NSLOT - 1) * SC_SLOT ? 0 : (so) + SC_SLOT)
    const int a_qk = l16 * 256, a_kp = 8192 + l16 * 32 + 8 * g, a_vt = 12288 + (16 * wave + l16) * 32 + 8 * g, a_dec = 16384 + 16 * g;
    f32x4 S[8];
#pragma unroll
    for (int j = 0; j < 8; ++j) S[j] = (f32x4){0.f, 0.f, 0.f, 0.f};
    bool keep[4];
#pragma unroll
    for (int i = 0; i < 4; ++i) keep[i] = dir ? (4 * g + i >= l16) : (4 * g + i <= l16);
    SC_DMA(0, 0); SC_DMA(1, SC_SLOT); SC_DMA(2, 2 * SC_SLOT);
    int so = 0, so_n = 3 * SC_SLOT;
    for (int ci = 0; ci < 528; ++ci) {
        if (ci >= 3 && ci + 3 < 528) asm volatile("s_waitcnt vmcnt(18) lgkmcnt(0)\n\ts_barrier" ::: "memory");
        else asm volatile("s_waitcnt vmcnt(0) lgkmcnt(0)\n\ts_barrier" ::: "memory");
        if (ci + 3 < 528) SC_DMA(ci + 3, so_n);
        const LAS unsigned char* sb = ldsl + so;
        bf16x8 qf[4], kf[4]; s16x4 kp[8]; f32x4 dec[8];
#pragma unroll
        for (int j2 = 0; j2 < 4; ++j2) { const int co = ((4 * j2 + g) ^ l16) * 16; qf[j2] = *(const LAS bf16x8*)(sb + a_qk + co); kf[j2] = *(const LAS bf16x8*)(sb + 4096 + a_qk + co); }
#pragma unroll
        for (int j = 0; j < 8; ++j) { kp[j] = *(const LAS s16x4*)(sb + a_kp + 512 * j); dec[j] = *(const LAS f32x4*)(sb + a_dec + 64 * j); }
        const s16x4 vt = *(const LAS s16x4*)(sb + a_vt);
        const int ch = SC_CHUNK(ci);
        f32x4 pt = {0.f, 0.f, 0.f, 0.f};
#pragma unroll
        for (int j2 = 0; j2 < 4; ++j2) pt = __builtin_amdgcn_mfma_f32_16x16x32_bf16(kf[j2], qf[j2], pt, 0, 0, 0);
        v2u paw; paw.x = pkbf(keep[0] ? pt[0] : 0.f, keep[1] ? pt[1] : 0.f); paw.y = pkbf(keep[2] ? pt[2] : 0.f, keep[3] ? pt[3] : 0.f);
        const s16x4 pa = __builtin_bit_cast(s16x4, paw);
        const bf16x8 pa8 = {pa[0], pa[1], pa[2], pa[3], 0, 0, 0, 0}, vt8 = {vt[0], vt[1], vt[2], vt[3], 0, 0, 0, 0};
        f32x4 o = __builtin_amdgcn_mfma_f32_16x16x32_bf16(pa8, vt8, (f32x4){0.f, 0.f, 0.f, 0.f}, 0, 0, 0);
#pragma unroll
        for (int j2 = 0; j2 < 4; ++j2) {
            v4u sw; sw.x = pkbf(S[2 * j2][0], S[2 * j2][1]); sw.y = pkbf(S[2 * j2][2], S[2 * j2][3]); sw.z = pkbf(S[2 * j2 + 1][0], S[2 * j2 + 1][1]); sw.w = pkbf(S[2 * j2 + 1][2], S[2 * j2 + 1][3]);
            o = __builtin_amdgcn_mfma_f32_16x16x32_bf16(qf[j2], __builtin_bit_cast(bf16x8, sw), o, 0, 0, 0);
        }
#pragma unroll
        for (int j = 0; j < 8; ++j) { const bf16x8 kp8 = {kp[j][0], kp[j][1], kp[j][2], kp[j][3], 0, 0, 0, 0}; S[j] = __builtin_amdgcn_mfma_f32_16x16x32_bf16(kp8, vt8, S[j] * dec[j], 0, 0, 0); }
        bf16* op = OB + (size_t)(ch * 16 + 4 * g) * BW + h * 128 + 16 * wave + l16;
#pragma unroll
        for (int i = 0; i < 4; ++i) op[(size_t)i * BW] = (bf16)(pkbf(o[i], 0.f) & 0xffffu);
        so = SC_NEXT(so); so_n = SC_NEXT(so_n);
    }
#undef SC_CHUNK
#undef SC_DMA
#undef SC_NEXT
}
__device__ __forceinline__ void mixer_phase(KArgs P, int l, unsigned char* lds_generic, LAS unsigned char* ldsl, volatile LAS unsigned* MISC, gu32* ctl, int tid, int wave, int lane) {
    static_assert(DEPTH == 2, "conversion unit split");
    const int conv_first = l == 0 ? I_IN : I_LAYER + I_IN, conv_end = l == 0 ? I_LAYER + I_IN : DEPTH * I_LAYER;
    const int n_main = 40 + 768 + 1280, n_att = n_main + (l == 0 ? 64 : 0), total = n_att + (conv_end - conv_first + CONV_UNIT - 1) / CONV_UNIT;
    const bf16* qkv = (const bf16*)(P->ws + WS_QKV); bf16* mix = (bf16*)(P->ws + WS_MIX); bf16* oc = (bf16*)(P->ws + WS_OC);
    for (;;) {
        __syncthreads();
        if (wave == 0 && opaque_lane() == 0) MISC[4] = __hip_atomic_fetch_add((unsigned*)(ctl + CW_WQ + 64 * l), 1u, __ATOMIC_RELAXED, __HIP_MEMORY_SCOPE_AGENT);
        __syncthreads();
        const int u = __builtin_amdgcn_readfirstlane((int)MISC[4]);
        if (u >= total) break;
        if (u >= n_att) {
            LAS float* scr = (LAS float*)(ldsl + wave * 16384); const int ln = opaque_lane();
            conv_run<CONV_PER_WAVE>(P, conv_first + (u - n_att) * CONV_UNIT + wave, 8, conv_end - 1, scr, ln);
            continue; }
#ifndef ATT_SD
#define ATT_SD 1
#endif
#ifndef MIX_MASK
#define MIX_MASK 7
#endif
        if (u < 40) { if (MIX_MASK & 1) scan_unit(P, u, wave, ldsl); if (DBL & 1024) { __syncthreads(); scan_unit(P, u, wave, ldsl); __syncthreads(); scan_unit(P, u, wave, ldsl); } continue; }
        const bool isA = (u < 808) || (u >= n_main && u < n_main + 24);
        if (isA) {
            int hq, b, qrow; int seq;
            if (u < 808) { const int v = u - 40, g = v % 3, qb = (v / 3) & 31, kvh = (v / 96) & 3; b = v / 384; hq = kvh * 3 + g; qrow = CTX + 256 * qb; seq = ROWS_B; }
            else { const int v = u - n_main; hq = v % 12; b = v / 12; qrow = 0; seq = CTX; }
            const int kvh = hq / 3; const size_t rq = (size_t)b * ROWS_B + qrow, rk = (size_t)b * ROWS_B;
            if (MIX_MASK & 2) att::attn_body<128, false>(qkv + rq * INC + C_AQ + 128 * hq, qkv + rk * INC + C_AK + 128 * kvh, qkv + rk * INC + C_AV + 128 * kvh, mix + rq * DM + 128 * hq, DM, seq, (char*)lds_generic, wave);
        } else {
            int m, h, b, qrow; int seq;
            if (u < n_main) { const int v = u - 808; m = v & 1; const int qb = (v >> 1) & 31; h = (v >> 6) % 10; b = v / 640; qrow = CTX + 256 * qb; seq = ROWS_B; }
            else { const int v = u - n_main - 24; m = v & 1; h = (v >> 1) % 10; b = v / 20; qrow = 0; seq = CTX; }
            const size_t rq = (size_t)b * ROWS_B + qrow, rk = (size_t)b * ROWS_B;
            if (MIX_MASK & 4) att::attn_body<64, true>(qkv + rq * INC + C_CQ + 128 * h + 64 * m, qkv + rk * INC + C_CK + 128 * h + 64 * m, qkv + rk * INC + C_CV + 128 * h, oc + rq * 2560 + 128 * (2 * h + m), 2560, seq, (char*)lds_generic, wave);
        }
    }
}
__device__ __forceinline__ void finalize_phase(KArgs P, int l, int gw, int NGW, int lane) {
    const float lam_init = (l == 0) ? 0.2f : 0.35550906759f;
    const float* dl = P->in[14] + l * 256;
    const float lam = __expf(wave_sum(dl[lane] * dl[64 + lane])) - __expf(wave_sum(dl[128 + lane] * dl[192 + lane])) + lam_init;
    const f32x2 gdo = *(const f32x2*)(P->in[15] + l * 128 + 2 * lane), gho = *(const f32x2*)(P->in[11] + l * 128 + 2 * lane);
    const bf16* oc = (const bf16*)(P->ws + WS_OC); const bf16* obf = (const bf16*)(P->ws + WS_OB); const bf16* obb = obf + (size_t)MROWS * BW;
    const bf16* qkv = (const bf16*)(P->ws + WS_QKV); bf16* mix = (bf16*)(P->ws + WS_MIX);
    for (int row = gw; row < MROWS; row += NGW) {
        if (l == DEPTH - 1 && (row % ROWS_B) < CTX) continue;
        unsigned* mrow = (unsigned*)(mix + (size_t)row * DM);
        f32x2 c0[10], c1[10], bf_[10], bb_[10]; unsigned gt[10];
#pragma unroll
        for (int h = 0; h < 10; ++h) { const unsigned t0 = *(const unsigned*)(oc + (size_t)row * 2560 + 256 * h + 2 * lane), t1 = *(const unsigned*)(oc + (size_t)row * 2560 + 256 * h + 128 + 2 * lane);
            c0[h] = (f32x2){__uint_as_float(t0 << 16), __uint_as_float(t0 & 0xffff0000u)}; c1[h] = (f32x2){__uint_as_float(t1 << 16), __uint_as_float(t1 & 0xffff0000u)}; }
#pragma unroll
        for (int h = 0; h < 10; ++h) { const unsigned tf = *(const unsigned*)(obf + (size_t)row * BW + 128 * h + 2 * lane), tb = *(const unsigned*)(obb + (size_t)row * BW + 128 * h + 2 * lane);
            bf_[h] = (f32x2){__uint_as_float(tf << 16), __uint_as_float(tf & 0xffff0000u)}; bb_[h] = (f32x2){__uint_as_float(tb << 16), __uint_as_float(tb & 0xffff0000u)};
            gt[h] = *(const unsigned*)(qkv + (size_t)row * INC + C_BG + 128 * h + 2 * lane); }
#pragma unroll
        for (int h = 0; h < 10; ++h) {
            const f32x2 d = c0[h] - c1[h] * lam;
            const float r = __builtin_amdgcn_rsqf(wave_sum(d.x * d.x + d.y * d.y) * (1.f / 128.f) + EPS) * (1.0f - lam_init);
            mrow[(2816 + 128 * h) / 2 + lane] = pkbf(d.x * r * gdo.x, d.y * r * gdo.y);
        }
#pragma unroll
        for (int h = 0; h < 10; ++h) {
            const f32x2 a = bf_[h] + bb_[h];
            const float r = __builtin_amdgcn_rsqf(wave_sum(a.x * a.x + a.y * a.y) * (1.f / 128.f) + EPS);
            mrow[(1536 + 128 * h) / 2 + lane] = pkbf(a.x * r * gho.x * silu_f(bflo(gt[h])), a.y * r * gho.y * silu_f(bfhi(gt[h])));
        }
    }
}
__global__ void __launch_bounds__(NTHR, 2) hybrid_fwd(Args args) {
    extern __shared__ __attribute__((aligned(16))) unsigned char lds[];
    LAS unsigned char* ldsl = (LAS unsigned char*)lds;
    volatile LAS unsigned* MISC = (volatile LAS unsigned*)(ldsl + MISC_OFF);
    const int G = gridDim.x, bx = blockIdx.x;
    const int wave_s = __builtin_amdgcn_readfirstlane((int)(threadIdx.x >> 6));
#define PH_IDS const int lane = opaque_lane(), wave = opaque_s(wave_s), tid = wave * 64 + lane; (void)tid; (void)lane; (void)wave; const int lq = opaque_s(l); (void)lq;
#define GW (bx * NWAVES + wave)
#define NGW (G * NWAVES)
#define GTID (bx * NTHR + tid)
#define NGT (G * NTHR)
    for (int u = threadIdx.x; u < (LDS_BYTES - RING_BYTES) / 4; u += NTHR) ((LAS unsigned*)(ldsl + RING_BYTES))[u] = 0u;
    __syncthreads();
    const int lo = args.ph_lo, hi = args.ph_hi;
    XcdBarrier bar; bar.bar = (unsigned*)(args.ws + WS_CTL) + CW_BAR; bar.x = 0; bar.st = nullptr;
    if (hi - lo > 1) bar = xcd_barrier_post((unsigned*)(args.ws + WS_CTL) + CW_BAR, MISC + 8);
#ifndef PH_MASK
#define PH_MASK 0xFFFFFFFFu
#endif
#define IN(k) (lo <= (k) && (k) < hi)
#define EN(k) ((PH_MASK >> (k)) & 1u)
#define SEAM(k) do { if (IN(k) && IN((k) + 1)) xcd_barrier(bar); } while (0)

    if (EN(0) && IN(0)) { const int l = 0; PH_IDS p0_prologue(fresh_args(), ldsl, GW, NGW, wave, lane); if (DBL & 17) { __syncthreads(); p0_prologue(fresh_args(), ldsl, GW, NGW, wave, lane); } } SEAM(0);
    if (EN(1) && IN(1)) { const int l = 0; PH_IDS p1_modreduce(fresh_args(), GTID, NGT); } SEAM(1);

#pragma unroll
    for (int l = 0; l < DEPTH; ++l) {
        const int pb = 2 + 9 * l;
        if (EN(2) && IN(pb + 0)) { PH_IDS norm_phase(fresh_args(), lq, 0, 1, lq == 0, 0, lq > 0, GW, NGW, lane); if (DBL & 33) norm_phase(fresh_args(), lq, 0, 1, lq == 0, 0, lq > 0, GW, NGW, lane); } SEAM(pb + 0);
        if (EN(3) && IN(pb + 1)) {
            const int lq = opaque_s(l); KArgs P = fresh_args(); unsigned char* ws = P->ws;
            pg8::Gemm g{(const pg8::bf16_t*)(ws + WS_HX), (const pg8::bf16_t*)(ws + WS_WIN + lq * SZ_WIN), MROWS, INC, DM}; pg8::PanelOrder S; S.init(INC, G, bx, lq == DEPTH - 1, lq == DEPTH - 1 ? 58 : 0, 0, 0, WGM_IN);
            pg8::EpiInproj E{(pg8::bf16_t*)(ws + WS_QKV), INC, P->in[8] + lq * 128, P->in[9] + lq * 128, P->in[12] + lq * 64, P->in[13] + lq * 64, (LAS float*)(ldsl + RING_BYTES + 2048)};
            pg8::gemm_phase<pg8::EpiInproj, pg8::PanelOrder, true, true>(ldsl, g, S, E, opaque_s(wave_s));
            if (DBL & 2) { __syncthreads(); pg8::gemm_phase<pg8::EpiInproj, pg8::PanelOrder, true, true>(ldsl, g, S, E, opaque_s(wave_s)); }
        } SEAM(pb + 1);
        if (EN(4) && IN(pb + 2)) { PH_IDS scanprep_phase(fresh_args(), lq, GTID, NGT); if (DBL & 65) scanprep_phase(fresh_args(), lq, GTID, NGT); } SEAM(pb + 2);
        if (EN(5) && IN(pb + 3)) { PH_IDS KArgs P = fresh_args(); mixer_phase(P, lq, lds, ldsl, MISC, (gu32*)(P->ws + WS_CTL), tid, wave, lane); if (DBL & 4) { __syncthreads(); mixer_phase(P, lq, lds, ldsl, MISC, (gu32*)(P->ws + WS_CTL) + 2048, tid, wave, lane); } } SEAM(pb + 3);
        if (EN(6) && IN(pb + 4)) { PH_IDS finalize_phase(fresh_args(), lq, GW, NGW, lane); if (DBL & 129) finalize_phase(fresh_args(), lq, GW, NGW, lane); } SEAM(pb + 4);
        if (EN(7) && IN(pb + 5)) {
            const int lq = opaque_s(l); KArgs P = fresh_args(); unsigned char* ws = P->ws; float* xres = (float*)(ws + WS_XRES);
            pg8::Gemm g{(const pg8::bf16_t*)(ws + WS_MIX), (const pg8::bf16_t*)(ws + WS_WOUT + lq * SZ_WOUT), MROWS, DM, DM}; pg8::PanelOrder S; S.init(DM, G, bx, 1, 0, lq != DEPTH - 1, DM / 64, WGM_OUT);
            pg8::EpiResGate E{xres, xres, (const float*)(ws + WS_MOD) + (size_t)lq * 3 * 24576, 2 * DM, 0, lq == 0, P->in[0], P->in[2], (float*)(ws + WS_PART)};
            if (DBL & 256) { pg8::EpiResGate E2 = E; E2.out = (float*)(ws + WS_OC); pg8::gemm_phase<pg8::EpiResGate, pg8::PanelOrder, true, true>(ldsl, g, S, E2, opaque_s(wave_s)); __syncthreads(); }
            pg8::gemm_phase<pg8::EpiResGate, pg8::PanelOrder, true, true>(ldsl, g, S, E, opaque_s(wave_s));
        } SEAM(pb + 5);
        if (EN(8) && IN(pb + 6)) { PH_IDS norm_phase(fresh_args(), lq, 3, 4, 0, lq == DEPTH - 1, lq < DEPTH - 1, GW, NGW, lane); if (DBL & 33) norm_phase(fresh_args(), lq, 3, 4, 0, lq == DEPTH - 1, lq < DEPTH - 1, GW, NGW, lane); } SEAM(pb + 6);
        if (EN(9) && IN(pb + 7)) {
            const int lq = opaque_s(l); KArgs P = fresh_args(); unsigned char* ws = P->ws;
            pg8::Gemm g{(const pg8::bf16_t*)(ws + WS_HX), (const pg8::bf16_t*)(ws + WS_WGU + lq * SZ_WGU), MROWS, 2 * DFF, DM}; pg8::PanelOrder S; S.init(2 * DFF, G, bx, lq == DEPTH - 1, 0, 0, 0, WGM_GU);
            pg8::EpiSwiglu E{(pg8::bf16_t*)(ws + WS_QKV), DFF};
            pg8::gemm_phase<pg8::EpiSwiglu, pg8::PanelOrder, true, true>(ldsl, g, S, E, opaque_s(wave_s));
            if (DBL & 8) { __syncthreads(); pg8::gemm_phase<pg8::EpiSwiglu, pg8::PanelOrder, true, true>(ldsl, g, S, E, opaque_s(wave_s)); }
        } SEAM(pb + 7);
        if (EN(10) && IN(pb + 8)) {
            const int lq = opaque_s(l); KArgs P = fresh_args(); unsigned char* ws = P->ws; float* xres = (float*)(ws + WS_XRES);
            pg8::Gemm g{(const pg8::bf16_t*)(ws + WS_QKV), (const pg8::bf16_t*)(ws + WS_WDN + lq * SZ_WDN), MROWS, DM, DFF}; pg8::PanelOrder S; S.init(DM, G, bx, 1, 0, lq != DEPTH - 1, DFF / 64, WGM_DN);
            pg8::EpiResGate E{xres, (lq == DEPTH - 1) ? P->out : xres, (const float*)(ws + WS_MOD) + (size_t)lq * 3 * 24576, 5 * DM, (lq == DEPTH - 1) ? 1 : 0, 0, nullptr, nullptr, (float*)(ws + WS_PART)};
            if (DBL & 512) { pg8::EpiResGate E2 = E; E2.out = (float*)(ws + WS_OC); E2.final_out = 0; pg8::gemm_phase<pg8::EpiResGate, pg8::PanelOrder, true, true>(ldsl, g, S, E2, opaque_s(wave_s)); __syncthreads(); }
            pg8::gemm_phase<pg8::EpiResGate, pg8::PanelOrder, true, true>(ldsl, g, S, E, opaque_s(wave_s));
        } SEAM(pb + 8);
    }
#undef IN
#undef SEAM
}

extern "C" void kernel_launch(void* const* d_in, const int* in_sizes, int n_in, void* d_out, int out_size, void* d_ws, size_t ws_size, hipStream_t stream) {
    static int grid = 0;
    if (grid == 0) {
        if (n_in != 19 || out_size != NB * SEQ * DM || ws_size < WS_END) { fprintf(stderr, "kernel_launch: shape/workspace mismatch: n_in %d out %d ws %zu (need %zu)\n", n_in, out_size, ws_size, (size_t)WS_END); grid = -1; return; }
        int dev = 0, cus = 0, per_cu = 0;
        if (hipGetDevice(&dev) != hipSuccess || hipDeviceGetAttribute(&cus, hipDeviceAttributeMultiprocessorCount, dev) != hipSuccess) { grid = -1; return; }
        if (hipFuncSetAttribute((const void*)hybrid_fwd, hipFuncAttributeMaxDynamicSharedMemorySize, LDS_BYTES) != hipSuccess) { fprintf(stderr, "kernel_launch: hipFuncSetAttribute failed\n"); grid = -1; return; }
        if (hipOccupancyMaxActiveBlocksPerMultiprocessor(&per_cu, (const void*)hybrid_fwd, NTHR, LDS_BYTES) != hipSuccess || per_cu < 1) { fprintf(stderr, "kernel_launch: occupancy query says %d\n", per_cu); }
        (void)hipGetLastError();
        grid = cus;
    }
    if (grid < 0) return;
    if (hipMemsetAsync((char*)d_ws + WS_CTL, 0, CTL_ZERO_BYTES, stream) != hipSuccess) return;
    Args a{};
    for (int i = 0; i < 19; ++i) a.in[i] = (const float*)d_in[i];
    a.out = (float*)d_out; a.ws = (unsigned char*)d_ws;
#if MK_ONE_LAUNCH
    a.ph_lo = 0; a.ph_hi = N_PHASES;
    hipLaunchKernelGGL(hybrid_fwd, dim3(grid), dim3(NTHR), LDS_BYTES, stream, a);
#else
    for (int p = 0; p < N_PHASES; ++p) { a.ph_lo = p; a.ph_hi = p + 1; hipLaunchKernelGGL(hybrid_fwd, dim3(grid), dim3(NTHR), LDS_BYTES, stream, a); }
#endif
}
```

```cpp
#include <hip/hip_runtime.h>
#include <cstdio>
#include <cstdint>
__device__ __forceinline__ int opaque_lane() { int t = __builtin_amdgcn_mbcnt_hi(~0u, __builtin_amdgcn_mbcnt_lo(~0u, 0u)); asm volatile("" : "+v"(t)); return t; }
__device__ __forceinline__ int opaque_s(int v) { asm volatile("" : "+s"(v)); return v; }
namespace pg8 {
#define PG8_LAS __attribute__((address_space(3)))
typedef unsigned short bf16_t;
typedef short bf16x8 __attribute__((ext_vector_type(8)));
typedef float f32x4 __attribute__((ext_vector_type(4)));
typedef unsigned u32x4 __attribute__((ext_vector_type(4)));
constexpr int BM = 256, BK = 64, HALF = 128, HTB = HALF * BK * 2  , STAGE_BYTES = 8 * HTB, NXCD = 8, WGM = 8;

__host__ __device__ __forceinline__ int lds_byte(int r, int c) { const int st = (r >> 4) * 2 + (c >> 5), rr = r & 15, cc = c & 31, ob = rr * 64 + cc * 2; return st * 1024 + (ob ^ (((ob >> 9) & 1) << 5)); }
__host__ __device__ __forceinline__ void stage_rc(int b, int& R, int& C) { const int st = b / 1024, sb = b % 1024, swz = sb ^ (((sb >> 9) & 1) << 5); R = (st >> 1) * 16 + swz / 64; C = (st & 1) * 32 + (swz % 64) / 2; }
__host__ __device__ __forceinline__ int perm32(int rho) { const int n = rho >> 4, i = rho & 15; return 8 * (i >> 2) + 4 * n + (i & 3); }

struct Unit { int pm, pn, kt0, nt, sl; };
struct Gemm { const bf16_t* A; const bf16_t* Bt; int M, N, K; };

struct StaticOrder {
    int nM, nN, nwg, G, c, wgm;
    __host__ __device__ void init(int M, int N, int G_, int c_, int wgm_ = WGM) { nM = M / BM; nN = N / BM; nwg = nM * nN; G = G_; c = c_; wgm = wgm_; }
    __host__ __device__ bool next(int i, Unit& u) const {
        const long L = (long)i * G + c; if (L >= nwg) return false;
        int wgid = (int)L; { const int q = nwg / NXCD, r = nwg % NXCD, xcd = wgid % NXCD, off = wgid / NXCD; wgid = (xcd < r ? xcd * (q + 1) : r * (q + 1) + (xcd - r) * q) + off; }
        const int nig = wgm * nN, gid = wgid / nig, fm = gid * wgm, gsz = (nM - fm) < wgm ? (nM - fm) : wgm;
        u.pm = fm + ((wgid % nig) % gsz); u.pn = (wgid % nig) / gsz; u.kt0 = 0; u.nt = 0; u.sl = 0; return true;
    }
    __device__ __forceinline__ void a_ready(const Unit&) const {}
    __device__ __forceinline__ void done(const Unit&) const {}
};
struct PanelOrder {
    StaticOrder so; int skip, extra, slices, ktiles;
    __host__ __device__ void init(int N, int G_, int c_, int skip_, int extra_, int slices_ = 0, int ktiles_ = 0, int wgm_ = WGM) { skip = skip_; extra = extra_; slices = slices_; ktiles = ktiles_; so.init(skip_ ? 16384 : 16896, N, G_, c_, wgm_); }
    __host__ __device__ bool next(int i, Unit& u) const {
        if (so.next(i, u)) { if (skip) u.pm += 1 + (u.pm >= 32 ? 1 : 0); return true; }
        const long L = (long)i * so.G + so.c - so.nwg;
        if (slices) { if (L >= 2 * so.nN * 8) return false;
            const int tl = (int)(L >> 3), sl = (int)(L & 7); u.pm = (tl >= so.nN) ? 33 : 0; u.pn = tl % so.nN;
            const int base = (ktiles / 16) * 2, rem = (ktiles - base * 8) / 2;
            u.nt = base + (sl < rem ? 2 : 0); u.kt0 = sl * base + 2 * (sl < rem ? sl : rem); u.sl = sl; return true; }
        if (L >= extra) return false;
        u.pm = (L >= 29) ? 33 : 0; u.pn = 21 + (int)(L % 29); u.kt0 = 0; u.nt = 0; u.sl = 0; return true;
    }
    __device__ __forceinline__ void a_ready(const Unit&) const {}
    __device__ __forceinline__ void done(const Unit&) const {}
};

typedef float f32x2 __attribute__((ext_vector_type(2)));
typedef __bf16 bf16x2_c __attribute__((ext_vector_type(2)));
__device__ __forceinline__ unsigned cvt_pk_bf16(float lo, float hi) { f32x2 v = {lo, hi}; bf16x2_c b = __builtin_convertvector(v, bf16x2_c); return __builtin_bit_cast(unsigned, b); }
constexpr int ROWS_B = 8448, PAN_B = 33;
struct EpiStore {
    static constexpr bool PERM = true, AFTER_DRAIN = false;
    bf16_t* O; int ldc;
    __device__ __forceinline__ void operator()(const f32x4 (&acc)[2][2][4][2], const Unit& u, int wr, int wc, int fr, int fq) const {
        const int row0 = u.pm * BM + wr * 64 + fr, col0 = u.pn * BM + wc * 32 + 8 * fq;
#pragma unroll
        for (int ai = 0; ai < 2; ++ai)
#pragma unroll
            for (int m = 0; m < 4; ++m) { bf16_t* rowp = O + (size_t)(row0 + ai * HALF + m * 16) * ldc + col0;
#pragma unroll
                for (int bj = 0; bj < 2; ++bj) { const f32x4 v0 = acc[ai][bj][m][0], v1 = acc[ai][bj][m][1];
                    u32x4 w; w.x = cvt_pk_bf16(v0[0], v0[1]); w.y = cvt_pk_bf16(v0[2], v0[3]); w.z = cvt_pk_bf16(v1[0], v1[1]); w.w = cvt_pk_bf16(v1[2], v1[3]);
                    *(u32x4*)(rowp + bj * HALF) = w; } }
    }
};
struct EpiInproj {
    static constexpr bool PERM = true, AFTER_DRAIN = false;
    bf16_t* O; int ldc; const float* aq_g; const float* ak_g; const float* dq_g; const float* dk_g; PG8_LAS float* xs;
    __device__ __forceinline__ void operator()(const f32x4 (&acc)[2][2][4][2], const Unit& u, int wr, int wc, int fr, int fq) const {
        const int row0 = u.pm * BM + wr * 64 + fr, col0 = u.pn * BM + wc * 32 + 8 * fq;
        const int pn = u.pn, kind = pn < 6 ? 1 : pn < 11 ? 2 : (pn == 21 || pn == 22) ? 3 : (pn >= 25 && pn < 30) ? 4 : 0;
        if (kind == 0) {
#pragma unroll
            for (int ai = 0; ai < 2; ++ai)
#pragma unroll
                for (int m = 0; m < 4; ++m) { bf16_t* rowp = O + (size_t)(row0 + ai * HALF + m * 16) * ldc + col0;
#pragma unroll
                    for (int bj = 0; bj < 2; ++bj) { const f32x4 v0 = acc[ai][bj][m][0], v1 = acc[ai][bj][m][1];
                        u32x4 w; w.x = cvt_pk_bf16(v0[0], v0[1]); w.y = cvt_pk_bf16(v0[2], v0[3]); w.z = cvt_pk_bf16(v1[0], v1[1]); w.w = cvt_pk_bf16(v1[2], v1[3]);
                        *(u32x4*)(rowp + bj * HALF) = w; } }
            return;
        }
        const bool isA = (kind & 1) != 0, isq = kind <= 2;
#pragma unroll
        for (int ai = 0; ai < 2; ++ai)
#pragma unroll
            for (int m = 0; m < 4; ++m)
#pragma unroll
                for (int bj = 0; bj < 2; ++bj) { const f32x4 a = acc[ai][bj][m][0], c = acc[ai][bj][m][1];
                    float q = (a[0] * a[0] + a[1] * a[1]) + (a[2] * a[2] + a[3] * a[3]) + (c[0] * c[0] + c[1] * c[1]) + (c[2] * c[2] + c[3] * c[3]);
                    q += __int_as_float(__builtin_amdgcn_ds_swizzle(__float_as_int(q), 0x1f | (16 << 10)));
                    { auto rr = __builtin_amdgcn_permlane32_swap(__float_as_uint(q), __float_as_uint(q), false, false); q = __uint_as_float(rr[0]) + __uint_as_float(rr[1]); }
                    if (fq == 0) xs[((((wr * 2 + ai) * 4 + m) * 16 + fr) * 2 + bj) * 4 + wc] = q; }
        asm volatile("s_waitcnt lgkmcnt(0)\n\ts_barrier" ::: "memory");
        const float* gp = kind == 1 ? aq_g : kind == 3 ? ak_g : kind == 2 ? dq_g : dk_g;
        const int ch = isA ? (32 * wc + 8 * fq) : ((32 * wc + 8 * fq) & 63);
        const f32x4 g0 = *(const f32x4*)(gp + ch), g1 = *(const f32x4*)(gp + ch + 4);
        const float qs = isq ? (isA ? 0.12751743f : 0.18033688f) : 1.0f;
        const bool latent = (u.pm % PAN_B) != 0;
        const bool use_row = isA ? (wc < 2) : ((wc & 1) == 0);
        float inv[4];
#pragma unroll
        for (int k = 0; k < 4; ++k) { const int p = ch / 2 + k;
            inv[k] = isA ? __builtin_amdgcn_exp2f(-(float)(2 * (p & 31)) * (13.287712379549449f / 64.0f)) : __builtin_amdgcn_exp2f(-(float)(2 * (p & 15)) * (13.287712379549449f / 32.0f)); }
#pragma unroll
        for (int ai = 0; ai < 2; ++ai)
#pragma unroll
            for (int m = 0; m < 4; ++m) {
                const int row = row0 + ai * HALF + m * 16, t = row % ROWS_B - 256;
                float cs[4], sn[4];
#pragma unroll
                for (int k = 0; k < 4; ++k) { cs[k] = 1.f; sn[k] = 0.f; }
                if (latent) { const float pos = (float)(use_row ? (t >> 6) : (t & 63));
#pragma unroll
                    for (int k = 0; k < 4; ++k) { float rv = pos * inv[k] * 0.15915494309189535f; rv -= floorf(rv); cs[k] = __builtin_amdgcn_cosf(rv); sn[k] = __builtin_amdgcn_sinf(rv); } }
                bf16_t* rowp = O + (size_t)row * ldc + col0;
#pragma unroll
                for (int bj = 0; bj < 2; ++bj) {
                    const f32x4 t4 = *(const PG8_LAS f32x4*)(xs + ((((wr * 2 + ai) * 4 + m) * 16 + fr) * 2 + bj) * 4);
                    const float ssum = isA ? ((t4[0] + t4[1]) + (t4[2] + t4[3])) : (wc < 2 ? t4[0] + t4[1] : t4[2] + t4[3]);
                    const float rstd = __builtin_amdgcn_rsqf(ssum * (isA ? 1.f / 128.f : 1.f / 64.f) + 1e-6f) * qs;
                    const f32x4 y0 = acc[ai][bj][m][0] * g0 * rstd, y1 = acc[ai][bj][m][1] * g1 * rstd;
                    u32x4 w;
                    w.x = cvt_pk_bf16(y0[0] * cs[0] - y0[1] * sn[0], y0[0] * sn[0] + y0[1] * cs[0]); w.y = cvt_pk_bf16(y0[2] * cs[1] - y0[3] * sn[1], y0[2] * sn[1] + y0[3] * cs[1]);
                    w.z = cvt_pk_bf16(y1[0] * cs[2] - y1[1] * sn[2], y1[0] * sn[2] + y1[1] * cs[2]); w.w = cvt_pk_bf16(y1[2] * cs[3] - y1[3] * sn[3], y1[2] * sn[3] + y1[3] * cs[3]);
                    *(u32x4*)(rowp + bj * HALF) = w; }
            }
    }
};
struct EpiSwiglu {
    static constexpr bool PERM = true, AFTER_DRAIN = false;
    bf16_t* O; int ldc;
    __device__ __forceinline__ void operator()(const f32x4 (&acc)[2][2][4][2], const Unit& u, int wr, int wc, int fr, int fq) const {
        const int row0 = u.pm * BM + wr * 64 + fr, col0 = u.pn * HALF + wc * 32 + 8 * fq;
#pragma unroll
        for (int ai = 0; ai < 2; ++ai)
#pragma unroll
            for (int m = 0; m < 4; ++m) { bf16_t* rowp = O + (size_t)(row0 + ai * HALF + m * 16) * ldc + col0;
                float h[8];
#pragma unroll
                for (int n = 0; n < 2; ++n)
#pragma unroll
                    for (int i = 0; i < 4; ++i) { const float g = acc[ai][0][m][n][i], up = acc[ai][1][m][n][i];
                        h[n * 4 + i] = g * __builtin_amdgcn_rcpf(1.0f + __expf(-g)) * up; }
                u32x4 w; w.x = cvt_pk_bf16(h[0], h[1]); w.y = cvt_pk_bf16(h[2], h[3]); w.z = cvt_pk_bf16(h[4], h[5]); w.w = cvt_pk_bf16(h[6], h[7]);
                *(u32x4*)rowp = w; }
    }
};
typedef unsigned u32x2_e __attribute__((ext_vector_type(2)));
struct EpiResGate {
    static constexpr bool PERM = false, AFTER_DRAIN = false;
    const float* res; float* out; const float* modl; int goff; int final_out; int res_in; const float* xin; const float* cin; float* part;
    __device__ __forceinline__ void operator()(const f32x4 (&acc)[2][2][4][2], const Unit& u, int wr, int wc, int fr, int fq) const {
        const int b = u.pm / PAN_B, pl = u.pm % PAN_B, isctx = (pl == 0);
        if (final_out && isctx) return;
        const float* gate = modl + (isctx ? 2 : b) * 24576 + goff;
        const int col0 = u.pn * BM + wc * 32 + 4 * fq;
        f32x4 gv[2][2];
#pragma unroll
        for (int bj = 0; bj < 2; ++bj)
#pragma unroll
            for (int n = 0; n < 2; ++n) gv[bj][n] = *(const f32x4*)(gate + col0 + bj * HALF + n * 16);
        const float* rbase = isctx ? cin + (size_t)b * 256 * 4096 : xin + ((size_t)b * 8192 + (size_t)(pl - 1) * 256) * 4096;
        float* obase = out + ((size_t)b * 8192 + (size_t)(pl - 1) * 256) * 4096;
        const bf16_t* resb = (const bf16_t*)res + (size_t)u.pm * BM * 4096; bf16_t* outb = (bf16_t*)out + (size_t)u.pm * BM * 4096;
#define ERG_OFF(ai, m, bj, n) ((size_t)((ai) * HALF + wr * 64 + (m) * 16 + fr) * 4096 + col0 + (bj) * HALF + (n) * 16)
        if (u.nt) {
            float* pb = part + ((size_t)(u.sl * 512 + b * 256) * 4096);
#pragma unroll
            for (int ai = 0; ai < 2; ++ai)
#pragma unroll
                for (int m = 0; m < 4; ++m)
#pragma unroll
                    for (int bj = 0; bj < 2; ++bj)
#pragma unroll
                        for (int n = 0; n < 2; ++n) *(f32x4*)(pb + ERG_OFF(ai, m, bj, n)) = gv[bj][n] * acc[ai][bj][m][n];
            return;
        }
        if (res_in) {
#pragma unroll
            for (int ai = 0; ai < 2; ++ai)
#pragma unroll
                for (int mh = 0; mh < 2; ++mh) {
                    f32x4 x[2][2][2];
#pragma unroll
                    for (int m = 0; m < 2; ++m)
#pragma unroll
                        for (int bj = 0; bj < 2; ++bj)
#pragma unroll
                            for (int n = 0; n < 2; ++n) x[m][bj][n] = *(const f32x4*)(rbase + ERG_OFF(ai, 2 * mh + m, bj, n));
#pragma unroll
                    for (int m = 0; m < 2; ++m)
#pragma unroll
                        for (int bj = 0; bj < 2; ++bj)
#pragma unroll
                            for (int n = 0; n < 2; ++n) { const f32x4 y = x[m][bj][n] + gv[bj][n] * acc[ai][bj][2 * mh + m][n];
                                u32x2_e w; w.x = cvt_pk_bf16(y[0], y[1]); w.y = cvt_pk_bf16(y[2], y[3]); *(u32x2_e*)(outb + ERG_OFF(ai, 2 * mh + m, bj, n)) = w; }
                }
            return;
        }
        {
#pragma unroll
            for (int ai = 0; ai < 2; ++ai) {
                u32x2_e xb[4][2][2];
#pragma unroll
                for (int m = 0; m < 4; ++m)
#pragma unroll
                    for (int bj = 0; bj < 2; ++bj)
#pragma unroll
                        for (int n = 0; n < 2; ++n) xb[m][bj][n] = *(const u32x2_e*)(resb + ERG_OFF(ai, m, bj, n));
#pragma unroll
                for (int m = 0; m < 4; ++m)
#pragma unroll
                    for (int bj = 0; bj < 2; ++bj)
#pragma unroll
                        for (int n = 0; n < 2; ++n) { const u32x2_e t = xb[m][bj][n];
                            const f32x4 x = (f32x4){__uint_as_float(t.x << 16), __uint_as_float(t.x & 0xffff0000u), __uint_as_float(t.y << 16), __uint_as_float(t.y & 0xffff0000u)};
                            const f32x4 y = x + gv[bj][n] * acc[ai][bj][m][n];
                            if (final_out) *(f32x4*)(obase + ERG_OFF(ai, m, bj, n)) = y;
                            else { u32x2_e w; w.x = cvt_pk_bf16(y[0], y[1]); w.y = cvt_pk_bf16(y[2], y[3]); *(u32x2_e*)(outb + ERG_OFF(ai, m, bj, n)) = w; } }
            }
        }
#undef ERG_OFF
    }
};
template <class Epi, class Sched, bool ALIGN_EPI = false, bool SP2 = false>
__device__ __forceinline__ void gemm_phase(PG8_LAS unsigned char* lds, const Gemm g, const Sched& S, const Epi& E, const int wid) {
    const int lane = opaque_lane(), tid = wid * 64 + lane, wr = wid >> 2, wc = wid & 3, fr = lane & 15, fq = lane >> 4;
    const int K = g.K, nt = K / BK;
    unsigned voffA[2], voffB[2];
#pragma unroll
    for (int i = 0; i < 2; ++i) { int R, C; stage_rc(tid * 16 + i * 8192, R, C); const int Rb = Epi::PERM ? ((R & ~31) + perm32(R & 31)) : R;
        voffA[i] = (unsigned)(R * K + C) * 2u; voffB[i] = (unsigned)(Rb * K + C) * 2u; }
    const size_t kstep = (size_t)(BK * 2);
    const size_t hstep = (size_t)HALF * K * 2;
    const size_t tstep = 2 * hstep;
    const unsigned ldsw = (unsigned)wid * 1024u;
    const int aoff = lds_byte(wr * 64 + fr, fq * 8), boff = lds_byte(wc * 32 + fr, fq * 8);
#define PG8_SA(b, h) (((b) * 2 + (h)) * HTB)
#define PG8_SB(b, h) ((4 + (b) * 2 + (h)) * HTB)
#define PG8_STAGE(bufoff, gbase, voff) do { _Pragma("unroll") for (int _i = 0; _i < 2; ++_i) \
        __builtin_amdgcn_global_load_lds((const unsigned*)((const char*)(gbase) + (voff)[_i]), (PG8_LAS unsigned*)(lds + (bufoff) + ldsw + _i * 8192), 16, 0, 0); } while (0)
#define PG8_LDA(dst, b, h) do { _Pragma("unroll") for (int m = 0; m < 4; ++m) _Pragma("unroll") for (int k = 0; k < 2; ++k) dst[m][k] = *(const PG8_LAS bf16x8*)(lds + PG8_SA(b, h) + aoff + m * 2048 + k * 1024); } while (0)
#define PG8_LDB(dst, b, h) do { _Pragma("unroll") for (int n = 0; n < 2; ++n) _Pragma("unroll") for (int k = 0; k < 2; ++k) dst[n][k] = *(const PG8_LAS bf16x8*)(lds + PG8_SB(b, h) + boff + n * 2048 + k * 1024); } while (0)
#define PG8_MMA(ai, bj, At, Bt) do { __builtin_amdgcn_s_setprio(1); _Pragma("unroll") for (int m = 0; m < 4; ++m) _Pragma("unroll") for (int n = 0; n < 2; ++n) _Pragma("unroll") for (int k = 0; k < 2; ++k) \
        acc[ai][bj][m][n] = __builtin_amdgcn_mfma_f32_16x16x32_bf16(Bt[n][k], At[m][k], acc[ai][bj][m][n], 0, 0, 0); __builtin_amdgcn_s_setprio(0); } while (0)
#define PG8_WAIT_V(n) asm volatile("s_waitcnt vmcnt(" #n ")" ::: "memory")
#define PG8_WAIT_L(n) asm volatile("s_waitcnt lgkmcnt(" #n ")" ::: "memory")
#define PG8_BAR __builtin_amdgcn_s_barrier()
#define PG8_SCHED __builtin_amdgcn_sched_barrier(0)
    Unit cur, nxt; int ui = 0;
    if (!S.next(0, cur)) return;
    f32x4 acc[2][2][4][2];
#pragma unroll
    for (int a = 0; a < 2; ++a)
#pragma unroll
        for (int b = 0; b < 2; ++b)
#pragma unroll
            for (int m = 0; m < 4; ++m)
#pragma unroll
                for (int n = 0; n < 2; ++n) acc[a][b][m][n] = (f32x4){0.f, 0.f, 0.f, 0.f};
    bf16x8 At[4][2], B0[2][2], B1[2][2];
    const char* cA = (const char*)g.A + (size_t)cur.pm * tstep + (size_t)cur.kt0 * kstep; const char* cB = (const char*)g.Bt + (size_t)cur.pn * tstep + (size_t)cur.kt0 * kstep;
    int cnt = cur.nt ? cur.nt : nt;
    S.a_ready(cur);
    if constexpr (SP2) {
        PG8_STAGE(PG8_SB(0, 0), cB, voffB); PG8_STAGE(PG8_SB(0, 1), cB + hstep, voffB); PG8_STAGE(PG8_SA(0, 0), cA, voffA); PG8_STAGE(PG8_SA(0, 1), cA + hstep, voffA);
        if (wr == 1) PG8_BAR;
        PG8_WAIT_V(2); PG8_BAR;
        PG8_STAGE(PG8_SB(1, 0), cB + kstep, voffB); PG8_STAGE(PG8_SA(1, 0), cA + kstep, voffA); PG8_STAGE(PG8_SB(1, 1), cB + hstep + kstep, voffB);
        PG8_WAIT_V(6); PG8_BAR;
    } else {
        PG8_STAGE(PG8_SB(0, 0), cB, voffB); PG8_STAGE(PG8_SA(0, 0), cA, voffA); PG8_STAGE(PG8_SB(0, 1), cB + hstep, voffB); PG8_STAGE(PG8_SA(0, 1), cA + hstep, voffA);
        if (wr == 1) PG8_BAR;
        PG8_WAIT_V(4); PG8_BAR;
        PG8_STAGE(PG8_SB(1, 0), cB + kstep, voffB); PG8_STAGE(PG8_SA(1, 0), cA + kstep, voffA); PG8_STAGE(PG8_SB(1, 1), cB + hstep + kstep, voffB);
        PG8_WAIT_V(6); PG8_BAR;
    }
    for (;;) {
        const bool has_next = S.next(ui + 1, nxt);
        const char* nA = has_next ? (const char*)g.A + (size_t)nxt.pm * tstep + (size_t)nxt.kt0 * kstep : cA; const char* nB = has_next ? (const char*)g.Bt + (size_t)nxt.pn * tstep + (size_t)nxt.kt0 * kstep : cB;
        for (int t = 0; t < cnt; t += 2) {
            const bool last = (t == cnt - 2);
            const char* a1 = cA + (size_t)(t + 1) * kstep;
            const char* a2 = last ? nA : cA + (size_t)(t + 2) * kstep; const char* b2 = last ? nB : cB + (size_t)(t + 2) * kstep;
            const char* a3 = a2 + kstep; const char* b3 = b2 + kstep;
            if (last && has_next) S.a_ready(nxt);
            if constexpr (SP2) {
            PG8_LDB(B0, 0, 0); PG8_LDB(B1, 0, 1); PG8_SCHED; PG8_LDA(At, 0, 0); PG8_STAGE(PG8_SA(1, 1), a1 + hstep, voffA);
            PG8_WAIT_V(8); PG8_WAIT_L(0); PG8_BAR; PG8_MMA(0, 0, At, B0); PG8_MMA(0, 1, At, B1); PG8_BAR; PG8_SCHED;
            PG8_LDA(At, 0, 1); PG8_STAGE(PG8_SB(0, 0), b2, voffB); PG8_STAGE(PG8_SB(0, 1), b2 + hstep, voffB); PG8_STAGE(PG8_SA(0, 0), a2, voffA);
            PG8_WAIT_V(8); PG8_WAIT_L(0); PG8_BAR; PG8_MMA(1, 0, At, B0); PG8_MMA(1, 1, At, B1); PG8_BAR; PG8_SCHED;
            PG8_LDB(B0, 1, 0); PG8_LDB(B1, 1, 1); PG8_SCHED; PG8_LDA(At, 1, 0); PG8_STAGE(PG8_SA(0, 1), a2 + hstep, voffA);
            PG8_WAIT_V(8); PG8_WAIT_L(0); PG8_BAR; PG8_MMA(0, 0, At, B0); PG8_MMA(0, 1, At, B1); PG8_BAR; PG8_SCHED;
            PG8_LDA(At, 1, 1); PG8_STAGE(PG8_SB(1, 0), b3, voffB); PG8_STAGE(PG8_SB(1, 1), b3 + hstep, voffB); PG8_STAGE(PG8_SA(1, 0), a3, voffA);
            PG8_WAIT_V(8); PG8_WAIT_L(0); PG8_BAR; PG8_MMA(1, 0, At, B0); PG8_MMA(1, 1, At, B1); PG8_BAR; PG8_SCHED;
            } else {
            PG8_LDB(B0, 0, 0); PG8_SCHED; PG8_LDA(At, 0, 0); PG8_STAGE(PG8_SA(1, 1), a1 + hstep, voffA);
            PG8_WAIT_L(8); PG8_BAR; PG8_WAIT_L(0); PG8_MMA(0, 0, At, B0); PG8_BAR; PG8_SCHED;
            PG8_LDB(B1, 0, 1); PG8_STAGE(PG8_SB(0, 0), b2, voffB);
            PG8_BAR; PG8_WAIT_L(0); PG8_MMA(0, 1, At, B1); PG8_BAR;
            PG8_LDA(At, 0, 1); PG8_STAGE(PG8_SA(0, 0), a2, voffA);
            PG8_BAR; PG8_WAIT_L(0); PG8_MMA(1, 0, At, B0); PG8_BAR; PG8_SCHED;
            PG8_STAGE(PG8_SB(0, 1), b2 + hstep, voffB);
            PG8_WAIT_V(6); PG8_BAR; PG8_MMA(1, 1, At, B1); PG8_BAR;
            PG8_LDB(B0, 1, 0); PG8_SCHED; PG8_LDA(At, 1, 0); PG8_STAGE(PG8_SA(0, 1), a2 + hstep, voffA);
            PG8_WAIT_L(8); PG8_BAR; PG8_WAIT_L(0); PG8_MMA(0, 0, At, B0); PG8_BAR; PG8_SCHED;
            PG8_LDB(B1, 1, 1); PG8_STAGE(PG8_SB(1, 0), b3, voffB);
            PG8_BAR; PG8_WAIT_L(0); PG8_MMA(0, 1, At, B1); PG8_BAR;
            PG8_LDA(At, 1, 1); PG8_STAGE(PG8_SA(1, 0), a3, voffA);
            PG8_BAR; PG8_WAIT_L(0); PG8_MMA(1, 0, At, B0); PG8_BAR; PG8_SCHED;
            PG8_STAGE(PG8_SB(1, 1), b3 + hstep, voffB);
            PG8_WAIT_V(6); PG8_BAR; PG8_MMA(1, 1, At, B1); PG8_BAR;
            }
        }
        if constexpr (ALIGN_EPI) { if (wr == 0) PG8_BAR; }
        if constexpr (!Epi::AFTER_DRAIN) { E(acc, cur, wr, wc, fr, fq); S.done(cur); }
        if (!has_next) break;
#pragma unroll
        for (int a = 0; a < 2; ++a)
#pragma unroll
            for (int b = 0; b < 2; ++b)
#pragma unroll
                for (int m = 0; m < 4; ++m)
#pragma unroll
                    for (int n = 0; n < 2; ++n) acc[a][b][m][n] = (f32x4){0.f, 0.f, 0.f, 0.f};
        cur = nxt; cA = nA; cB = nB; ++ui; cnt = cur.nt ? cur.nt : nt;
        if constexpr (ALIGN_EPI) { if (wr == 1) PG8_BAR; }
    }
    PG8_WAIT_V(0);
    if constexpr (!ALIGN_EPI) { if (wr == 0) PG8_BAR; }
    PG8_BAR;
    if constexpr (Epi::AFTER_DRAIN) { E.fused(acc, cur, wr, wc, fr, fq, lds, wid, lane); S.done(cur); }
#undef PG8_SA
#undef PG8_SB
#undef PG8_STAGE
#undef PG8_LDA
#undef PG8_LDB
#undef PG8_MMA
#undef PG8_WAIT_V
#undef PG8_WAIT_L
#undef PG8_BAR
#undef PG8_SCHED
}
}
namespace att {
typedef unsigned short bf16_t;
using bf16x8 = __attribute__((ext_vector_type(8))) short;
using s16x4  = __attribute__((ext_vector_type(4))) short;
using f32x16 = __attribute__((ext_vector_type(16))) float;
using u32x4  = __attribute__((ext_vector_type(4))) unsigned;
constexpr int NW = 8, QBLK = 32, KVBLK = 64, LDX = 12800;
constexpr float THR = 8.f;
constexpr int SHM_V = KVBLK * 128 * 2, SHM_K = KVBLK * 128 * 2, SHM_ATTN = 2 * SHM_V + 2 * SHM_K + NW * 64 * 4;
#define ATT_SBAR() __builtin_amdgcn_sched_barrier(0)
__device__ __forceinline__ int crow(int r, int hi) { return (r & 3) + 8 * (r >> 2) + 4 * hi; }
__device__ __forceinline__ unsigned cvtpk(float lo, float hi) { unsigned r; asm volatile("v_cvt_pk_bf16_f32 %0, %1, %2" : "=v"(r) : "v"(lo), "v"(hi)); return r; }
template <int DQK> __device__ __forceinline__ int kswz(int row, int colB) {
  if constexpr (DQK == 128) return row * 256 + (colB ^ ((row & 7) << 4));
  else return (row >> 1) * 256 + ((((row & 1) << 7) + colB) ^ (((row >> 1) & 7) << 4));
}

__device__ __forceinline__ void partialSM(f32x16&) {}
__device__ __forceinline__ void finishSM(f32x16& p0, f32x16& p1, float& l_reg, bf16x8& pa0, bf16x8& pa1, bf16x8& pa2, bf16x8& pa3) {
#pragma unroll
  for (int r = 0; r < 16; ++r) p0[r] = __builtin_amdgcn_exp2f(p0[r]);
#pragma unroll
  for (int r = 0; r < 16; ++r) p1[r] = __builtin_amdgcn_exp2f(p1[r]);
  float ps = 0;
#pragma unroll
  for (int r = 0; r < 16; ++r) ps += p0[r];
#pragma unroll
  for (int r = 0; r < 16; ++r) ps += p1[r];
  l_reg += ps;
#define ATT_PK4(P, BASE, OUT) do { unsigned a0 = cvtpk(P[BASE + 0], P[BASE + 1]), a1 = cvtpk(P[BASE + 2], P[BASE + 3]);   \
    unsigned b0 = cvtpk(P[BASE + 4], P[BASE + 5]), b1 = cvtpk(P[BASE + 6], P[BASE + 7]);                              \
    auto r0 = __builtin_amdgcn_permlane32_swap(a0, b0, false, false); auto r1 = __builtin_amdgcn_permlane32_swap(a1, b1, false, false); \
    u32x4 w = {r0[0], r1[0], r0[1], r1[1]}; OUT = *reinterpret_cast<bf16x8*>(&w); } while (0)
  ATT_PK4(p0, 0, pa0); ATT_PK4(p0, 8, pa1); ATT_PK4(p1, 0, pa2); ATT_PK4(p1, 8, pa3);
#undef ATT_PK4
}
template <int DQK> __device__ __forceinline__ void qkt(f32x16& p0, f32x16& p1, const char* Ks, const bf16x8* qr, int r32, int hi) {
  constexpr int N = DQK / 16;
  bf16x8 k0[2], k1[2];
  { const int cb = (hi * 8) * 2; k0[0] = *reinterpret_cast<const bf16x8*>(Ks + kswz<DQK>(r32, cb)); k1[0] = *reinterpret_cast<const bf16x8*>(Ks + kswz<DQK>(32 + r32, cb)); }
  p0 = f32x16{}; p1 = f32x16{};
#pragma unroll
  for (int d0 = 0; d0 < N; ++d0) {
    if (d0 + 1 < N) { const int cb = ((d0 + 1) * 16 + hi * 8) * 2;
      k0[(d0 + 1) & 1] = *reinterpret_cast<const bf16x8*>(Ks + kswz<DQK>(r32, cb)); k1[(d0 + 1) & 1] = *reinterpret_cast<const bf16x8*>(Ks + kswz<DQK>(32 + r32, cb)); }
    __builtin_amdgcn_sched_barrier(0x406);
    p0 = __builtin_amdgcn_mfma_f32_32x32x16_bf16(k0[d0 & 1], qr[d0], p0, 0, 0, 0);
    p1 = __builtin_amdgcn_mfma_f32_32x32x16_bf16(k1[d0 & 1], qr[d0], p1, 0, 0, 0);
    __builtin_amdgcn_sched_barrier(0x406);
  }
}
__device__ __forceinline__ int v_st(int k, int c) { const int kk = (k & ~0xC) | ((k & 4) << 1) | ((k & 8) >> 1); return ((kk >> 3) * 4 + (c >> 5)) * 512 + ((kk & 7) * 32 + (c & 31)) * 2; }
__device__ __forceinline__ int v_rd_base(int lane) { return ((lane & 3) << 3) | (((lane >> 2) & 3) << 6) | (((lane >> 4) & 1) << 5) | (((lane >> 5) & 1) << 8); }
constexpr int v_rd_off(int d0, int ks, int half) { return d0 * 512 + ks * 4096 + half * 2048; }
template <int OFF> __device__ __forceinline__ s16x4 tr_read(int vb) {
  s16x4 r; asm volatile("ds_read_b64_tr_b16 %0, %1 offset:%2" : "=&v"(r) : "v"(vb), "i"(OFF) : "memory"); return r;
}
template <int D0> __device__ __forceinline__ void pv_one(f32x16& od, int vb, bf16x8 pa0, bf16x8 pa1, bf16x8 pa2, bf16x8 pa3) {
  const s16x4 l0 = tr_read<v_rd_off(D0, 0, 0)>(vb), h0 = tr_read<v_rd_off(D0, 0, 1)>(vb), l1 = tr_read<v_rd_off(D0, 1, 0)>(vb), h1 = tr_read<v_rd_off(D0, 1, 1)>(vb);
  const s16x4 l2 = tr_read<v_rd_off(D0, 2, 0)>(vb), h2 = tr_read<v_rd_off(D0, 2, 1)>(vb), l3 = tr_read<v_rd_off(D0, 3, 0)>(vb), h3 = tr_read<v_rd_off(D0, 3, 1)>(vb);
  asm volatile("s_waitcnt lgkmcnt(0)" ::: "memory"); ATT_SBAR();
#define ATT_PK(L, H) (bf16x8){L[0], L[1], L[2], L[3], H[0], H[1], H[2], H[3]}
  od = __builtin_amdgcn_mfma_f32_32x32x16_bf16(pa0, ATT_PK(l0, h0), od, 0, 0, 0);
  od = __builtin_amdgcn_mfma_f32_32x32x16_bf16(pa1, ATT_PK(l1, h1), od, 0, 0, 0);
  od = __builtin_amdgcn_mfma_f32_32x32x16_bf16(pa2, ATT_PK(l2, h2), od, 0, 0, 0);
  od = __builtin_amdgcn_mfma_f32_32x32x16_bf16(pa3, ATT_PK(l3, h3), od, 0, 0, 0);
#undef ATT_PK
}
__device__ __forceinline__ void pv_d0(f32x16* o, int vb, bf16x8 pa0, bf16x8 pa1, bf16x8 pa2, bf16x8 pa3) {
  pv_one<0>(o[0], vb, pa0, pa1, pa2, pa3); pv_one<1>(o[1], vb, pa0, pa1, pa2, pa3); pv_one<2>(o[2], vb, pa0, pa1, pa2, pa3); pv_one<3>(o[3], vb, pa0, pa1, pa2, pa3);
}

constexpr int SLOT = 32768, SLOT_V = 16384, NSLOT = 3, ATT_LDS = NSLOT * SLOT + NW * 64 * 4;
__device__ __forceinline__ void glds16(const void* sbase, unsigned voff, unsigned lds_dst) {
  unsigned keep;
  asm volatile("s_mov_b32 %0, m0\n\ts_mov_b32 m0, %3\n\ts_nop 0\n\tglobal_load_lds_dwordx4 %1, %2\n\ts_mov_b32 m0, %0" : "=&s"(keep) : "v"(voff), "s"(sbase), "s"(lds_dst) : "memory");
}
#define ATT_WAIT_BAR() asm volatile("s_waitcnt vmcnt(0) lgkmcnt(0)\n\ts_barrier" ::: "memory")
template <int DQK, bool OUTF32>
__device__ __forceinline__ void attn_body(const bf16_t* __restrict__ Qb, const bf16_t* __restrict__ Kh, const bf16_t* __restrict__ Vh,
                                          void* __restrict__ Ob, const int ldo, const int seq, char* lds, const int wid) {
  const int lane = opaque_lane(), r32 = lane & 31, hi = lane >> 5;
  const unsigned lds0 = (unsigned)(uintptr_t)lds;
  float* li_l = (float*)(lds + NSLOT * SLOT) + wid * 64;
  float l_reg = 0; f32x16 o[4] = {}; bf16x8 qr[DQK / 16];
  const bf16_t* Qw = Qb + (long)(wid * QBLK + r32) * LDX + hi * 8;
#pragma unroll
  for (int d0 = 0; d0 < DQK / 16; ++d0) qr[d0] = *reinterpret_cast<const bf16x8*>(Qw + d0 * 16);
  unsigned offK[2], offV[2];
  if constexpr (DQK == 128) {
#pragma unroll
    for (int i = 0; i < 2; ++i) { const int row = 4 * (2 * wid + i) + (lane >> 4), colB = ((lane & 15) * 16) ^ ((row & 7) << 4); offK[i] = (unsigned)(row * (LDX * 2) + colB); }
  } else {
    const int sr = 4 * wid + (lane >> 4), x = ((lane & 15) * 16) ^ ((sr & 7) << 4), row = 2 * sr + (x >> 7); offK[0] = (unsigned)(row * (LDX * 2) + (x & 127)); offK[1] = 0;
  }
#pragma unroll
  for (int i = 0; i < 2; ++i) { const int sub = 2 * (2 * wid + i) + (lane >> 5), kk = (sub >> 2) * 8 + ((lane & 31) >> 2), c = (sub & 3) * 32 + (lane & 3) * 8;
    const int k = (kk & ~0xC) | ((kk & 4) << 1) | ((kk & 8) >> 1); offV[i] = (unsigned)(k * (LDX * 2) + c * 2); }
  const unsigned dstK = lds0 + (DQK == 128 ? 2 * wid : wid) * 1024, dstV = lds0 + SLOT_V + 2 * wid * 1024;
#define ATT_DMA(t, slotoff) do { const char* kb_ = (const char*)Kh + (size_t)(t) * (KVBLK * LDX * 2); const char* vb_ = (const char*)Vh + (size_t)(t) * (KVBLK * LDX * 2); \
    glds16(kb_, offK[0], dstK + (slotoff)); if constexpr (DQK == 128) glds16(kb_, offK[1], dstK + (slotoff) + 1024); \
    glds16(vb_, offV[0], dstV + (slotoff)); glds16(vb_, offV[1], dstV + (slotoff) + 1024); } while (0)
#define ATT_NEXT(so) ((so) == 2 * SLOT ? 0 : (so) + SLOT)
  const int vb0 = (int)lds0 + SLOT_V + v_rd_base(lane);
  f32x16 pA0, pA1, pB0, pB1; bf16x8 pa0, pa1, pa2, pa3; const int NT = seq / KVBLK;
  ATT_DMA(0, 0); ATT_DMA(1, SLOT);
  if constexpr (DQK == 128) asm volatile("s_waitcnt vmcnt(4)\n\ts_barrier" ::: "memory"); else asm volatile("s_waitcnt vmcnt(3)\n\ts_barrier" ::: "memory");
  qkt<DQK>(pA0, pA1, lds, qr, r32, hi); partialSM(pA0);
  ATT_WAIT_BAR();
  int so_p = 0, so_c = SLOT, so_n = 2 * SLOT;
  for (int j = 1; j + 1 < NT; j += 2) {
    ATT_SBAR(); qkt<DQK>(pB0, pB1, lds + so_c, qr, r32, hi);
    if (j + 1 < NT) ATT_DMA(j + 1, so_n);
    finishSM(pA0, pA1, l_reg, pa0, pa1, pa2, pa3); ATT_SBAR();
    pv_d0(o, vb0 + so_p, pa0, pa1, pa2, pa3); partialSM(pB0);
    ATT_WAIT_BAR();
    so_p = so_c; so_c = ATT_NEXT(so_c); so_n = ATT_NEXT(so_n);
    ATT_SBAR(); qkt<DQK>(pA0, pA1, lds + so_c, qr, r32, hi);
    if (j + 2 < NT) ATT_DMA(j + 2, so_n);
    finishSM(pB0, pB1, l_reg, pa0, pa1, pa2, pa3); ATT_SBAR();
    pv_d0(o, vb0 + so_p, pa0, pa1, pa2, pa3); partialSM(pA0);
    ATT_WAIT_BAR();
    so_p = so_c; so_c = ATT_NEXT(so_c); so_n = ATT_NEXT(so_n);
  }
  ATT_SBAR(); qkt<DQK>(pB0, pB1, lds + so_c, qr, r32, hi);
  finishSM(pA0, pA1, l_reg, pa0, pa1, pa2, pa3); ATT_SBAR();
  pv_d0(o, vb0 + so_p, pa0, pa1, pa2, pa3); partialSM(pB0);
  finishSM(pB0, pB1, l_reg, pa0, pa1, pa2, pa3); ATT_SBAR();
  pv_d0(o, vb0 + so_c, pa0, pa1, pa2, pa3);
  { auto rr = __builtin_amdgcn_permlane32_swap(__float_as_uint(l_reg), __float_as_uint(l_reg), false, false); l_reg = __uint_as_float(rr[0]) + __uint_as_float(rr[1]); }
  if (hi == 0) li_l[r32] = l_reg; asm volatile("s_waitcnt lgkmcnt(0)" ::: "memory");
  float rli[16];
#pragma unroll
  for (int r = 0; r < 16; ++r) rli[r] = __builtin_amdgcn_rcpf(li_l[crow(r, hi)]);
  if constexpr (OUTF32) {
    bf16_t* Ow = (bf16_t*)Ob + (long)(wid * QBLK) * ldo;
    const bool odd = (r32 & 1) != 0;
#pragma unroll
    for (int r = 0; r < 16; r += 2) { const int orow = crow(r, hi) + (odd ? 1 : 0);
#pragma unroll
      for (int d0 = 0; d0 < 4; ++d0) { const float xa = o[d0][r] * rli[r], xb = o[d0][r + 1] * rli[r + 1];
        const float send = odd ? xa : xb, keep = odd ? xb : xa;
        const float recv = __int_as_float(__builtin_amdgcn_mov_dpp(__float_as_int(send), 0xB1, 0xf, 0xf, true));
        const unsigned w = pg8::cvt_pk_bf16(odd ? recv : keep, odd ? keep : recv);
        *(unsigned*)(Ow + (long)orow * ldo + d0 * 32 + (r32 & ~1)) = w; } }
  } else {
    bf16_t* Ow = (bf16_t*)Ob + (long)(wid * QBLK) * ldo;
#pragma unroll
    for (int r = 0; r < 16; ++r) { const int orow = crow(r, hi);
#pragma unroll
      for (int d0 = 0; d0 < 4; ++d0) Ow[(long)orow * ldo + d0 * 32 + r32] = (bf16_t)(cvtpk(o[d0][r] * rli[r], 0.f) & 0xffffu); }
  }
#undef ATT_DMA
#undef ATT_NEXT
}
}
constexpr int NWAVES = 8, NTHR = 512;
constexpr int DM = 4096, NB = 2, SEQ = 8192, CTX = 256, DEPTH = 2, DFF = 11008, INC = 12800;
constexpr int ROWS_B = 8448, MROWS = NB * ROWS_B, NCHUNK = MROWS / 16;
constexpr int C_AQ = 0, C_CQ = 1536, C_BQ = 2816, C_BG = 4096, C_AK = 5376, C_AV = 5888, C_CK = 6400, C_CV = 7680, C_BI = 8960, C_BFF = 10240, C_BFB = 11520;
constexpr int BW = 1280;
constexpr float EPS = 1e-6f;
#ifndef DBL
#define DBL 0
#endif
#define WGM_IN 4
#define WGM_OUT 4
#define WGM_GU 4
#define WGM_DN 4
#ifndef MK_ONE_LAUNCH
#define MK_ONE_LAUNCH 1
#endif
constexpr int N_PHASES = 2 + 9 * DEPTH;

constexpr size_t MiB = 1u << 20;
constexpr size_t al256(size_t x) { return (x + 255) / 256 * 256; }
constexpr size_t WS_CTL = 0, CTL_ZERO_BYTES = 1 * MiB;
constexpr size_t SZ_WIN = (size_t)INC * DM * 2, SZ_WOUT = (size_t)DM * DM * 2, SZ_WGU = (size_t)2 * DFF * DM * 2, SZ_WDN = (size_t)DM * DFF * 2;
constexpr size_t WS_WIN = 1 * MiB, WS_WOUT = WS_WIN + DEPTH * SZ_WIN, WS_WGU = WS_WOUT + DEPTH * SZ_WOUT, WS_WDN = WS_WGU + DEPTH * SZ_WGU;
constexpr size_t WS_MODP = WS_WDN + DEPTH * SZ_WDN;
constexpr size_t WS_MOD = WS_MODP + (size_t)16 * 2 * 3 * 24576 * 4;
constexpr size_t WS_XRES = al256(WS_MOD + (size_t)2 * 3 * 24576 * 4);
constexpr size_t WS_HX = WS_XRES + (size_t)MROWS * DM * 4;
constexpr size_t WS_QKV = WS_HX + (size_t)MROWS * DM * 2;
constexpr size_t WS_MIX = WS_QKV + (size_t)MROWS * INC * 2;
constexpr size_t WS_OC = WS_MIX + (size_t)MROWS * DM * 2;
constexpr size_t SZ_SC = (size_t)MROWS * BW * 2;
constexpr size_t WS_QT = WS_OC + (size_t)MROWS * 2560 * 4;
constexpr size_t WS_KT = WS_QT + 2 * SZ_SC, WS_KP = WS_KT + 2 * SZ_SC, WS_VT = WS_KP + 2 * SZ_SC;
constexpr size_t WS_DEC = WS_VT + SZ_SC;
constexpr size_t WS_OB = WS_DEC + (size_t)2 * NCHUNK * BW * 4;
constexpr size_t WS_PART = WS_OB + (size_t)2 * MROWS * BW * 4;
constexpr size_t WS_END = WS_PART + (size_t)8 * 512 * DM * 4;
constexpr int CW_TMO = 0, CW_BAR = 4096, CW_WQ = 8192;

constexpr int RING_BYTES = 131072, MISC_OFF = RING_BYTES + 320, LDS_BYTES = 147456;

#define GAS __attribute__((address_space(1)))
#define LAS __attribute__((address_space(3)))
typedef unsigned short bf16;
typedef unsigned v4u __attribute__((ext_vector_type(4)));
typedef unsigned v2u __attribute__((ext_vector_type(2)));
typedef float f32x4 __attribute__((ext_vector_type(4)));
typedef float f32x2 __attribute__((ext_vector_type(2)));
typedef short bf16x8 __attribute__((ext_vector_type(8)));
typedef short s16x4 __attribute__((ext_vector_type(4)));
typedef GAS unsigned gu32;
#define RLX_AGENT __ATOMIC_RELAXED, __HIP_MEMORY_SCOPE_AGENT
#define LDS_WAIT() asm volatile("s_waitcnt lgkmcnt(0)" ::: "memory")
typedef __bf16 bf16x2_t __attribute__((ext_vector_type(2)));
__device__ __forceinline__ unsigned pkbf(float lo, float hi) { f32x2 v = {lo, hi}; bf16x2_t b = __builtin_convertvector(v, bf16x2_t); return __builtin_bit_cast(unsigned, b); }
__device__ __forceinline__ float bf2f(unsigned short h) { return __uint_as_float((unsigned)h << 16); }
__device__ __forceinline__ float bflo(unsigned w) { return __uint_as_float(w << 16); }
__device__ __forceinline__ float bfhi(unsigned w) { return __uint_as_float(w & 0xffff0000u); }
template <int M> __device__ __forceinline__ float swz_xor(float v) { return __int_as_float(__builtin_amdgcn_ds_swizzle(__float_as_int(v), 0x1f | (M << 10))); }
__device__ __forceinline__ float half_sum(float v) {
    v += swz_xor<1>(v); v += swz_xor<2>(v); v += swz_xor<4>(v); v += swz_xor<8>(v); v += swz_xor<16>(v);
    return v;
}
__device__ __forceinline__ float wave_sum(float v) {
    v = half_sum(v);
    auto rr = __builtin_amdgcn_permlane32_swap(__float_as_uint(v), __float_as_uint(v), false, false);
    return __uint_as_float(rr[0]) + __uint_as_float(rr[1]);
}
__device__ __forceinline__ float bcast_lane(float v, int j) { return __int_as_float(__builtin_amdgcn_readlane(__float_as_int(v), j)); }
__device__ __forceinline__ float silu_f(float x) { return x * __builtin_amdgcn_rcpf(1.0f + __expf(-x)); }
#define XB_TMO      128
#define XB_XCNT(j)  (256  + 64 * (j))
#define XB_XSUB(j)  (1280 + 64 * (j))
#define XB_XGEN(j)  (2304 + 64 * (j))
#define XB_TOP      3328
#define XB_TOPGEN   3392
#define XCD_BAR_WORDS 3456
#define XB_SPIN_CAP (1u << 18)

__device__ __forceinline__ unsigned xb_ld(unsigned* p)              { return __hip_atomic_load(p, __ATOMIC_RELAXED, __HIP_MEMORY_SCOPE_AGENT); }
__device__ __forceinline__ unsigned xb_add(unsigned* p, unsigned v) { return __hip_atomic_fetch_add(p, v, __ATOMIC_RELAXED, __HIP_MEMORY_SCOPE_AGENT); }
__device__ __forceinline__ unsigned xb_xcc_id() { return (unsigned)__builtin_amdgcn_s_getreg((3 << 11) | 20) & 0xFu; }
#define XB_SPIN(cond, bar) do { unsigned _sp = 0; while (cond) { __builtin_amdgcn_s_sleep(1); \
    if ((++_sp & 255u) == 0u) { if (xb_ld(&(bar)[XB_TMO])) break; if (_sp > XB_SPIN_CAP) { atomicAdd(&(bar)[XB_TMO], 1u); break; } } } } while (0)

struct XcdBarrier {
    unsigned* bar; unsigned x;
    volatile LAS unsigned* st;
};

__device__ __forceinline__ XcdBarrier xcd_barrier_post(unsigned* bar, volatile LAS unsigned* st) {
    XcdBarrier b; b.bar = bar; b.x = xb_xcc_id(); b.st = st;
    if (threadIdx.x == 0) (void)xb_add(&bar[XB_XCNT(b.x)], 1u);
    return b;
}
__device__ __forceinline__ void xcd_barrier_complete(unsigned* bar, unsigned x, unsigned& nloc, unsigned& nx) {
    const unsigned G = gridDim.x * gridDim.y * gridDim.z;
    unsigned sum, cnt, mine, sp = 0u;
    for (;;) {
        sum = 0u; cnt = 0u; mine = 0u;
#pragma unroll
        for (unsigned j = 0; j < 16; ++j) { const unsigned c = xb_ld(&bar[XB_XCNT(j)]); sum += c; cnt += (c > 0u) ? 1u : 0u; mine = (j == x) ? c : mine; }
        if (sum == G) break;
        __builtin_amdgcn_s_sleep(1);
        if ((++sp & 255u) == 0u) { if (xb_ld(&bar[XB_TMO])) break; if (sp > XB_SPIN_CAP) { atomicAdd(&bar[XB_TMO], 1u); break; } }
    }
    nloc = mine > 0u ? mine : 1u; nx = cnt > 0u ? cnt : 1u;
}

__device__ __forceinline__ void xcd_barrier(const XcdBarrier& b) {
    asm volatile("s_waitcnt vmcnt(0)" ::: "memory");
    __syncthreads();
    if (threadIdx.x == 0) {
        unsigned* bar = b.bar;
        __builtin_amdgcn_s_waitcnt(0);
        unsigned nloc = b.st[0], nx = b.st[1];
        if (nloc == 0u) { xcd_barrier_complete(bar, b.x, nloc, nx); b.st[0] = nloc; b.st[1] = nx; }
        const unsigned old = xb_add(&bar[XB_XSUB(b.x)], 1u);
        const unsigned gen = old / nloc;
        if (old + 1u == (gen + 1u) * nloc) {
            __builtin_amdgcn_fence(__ATOMIC_RELEASE, "agent");
            asm volatile("s_waitcnt vmcnt(0)" ::: "memory");
            const unsigned og = xb_add(&bar[XB_TOP], 1u);
            const unsigned tg = og / nx;
            if (og + 1u == (tg + 1u) * nx) xb_add(&bar[XB_TOPGEN], 1u);
            else XB_SPIN(xb_ld(&bar[XB_TOPGEN]) == tg, bar);
            __builtin_amdgcn_fence(__ATOMIC_ACQUIRE, "agent");
            xb_add(&bar[XB_XGEN(b.x)], 1u);
            asm volatile("s_waitcnt vmcnt(0)" ::: "memory");
        } else {
            XB_SPIN(xb_ld(&bar[XB_XGEN(b.x)]) == gen, bar);
            __builtin_amdgcn_fence(__ATOMIC_ACQUIRE, "agent");
            asm volatile("s_waitcnt vmcnt(0)" ::: "memory");
        }
    }
    __syncthreads();
}
struct Args { const float* in[19]; float* out; unsigned char* ws; int ph_lo, ph_hi; };
typedef const Args __attribute__((address_space(4)))* KArgs;
__device__ __forceinline__ KArgs fresh_args() { KArgs p = (KArgs)__builtin_amdgcn_kernarg_segment_ptr(); asm volatile("" : "+s"(p)); return p; }
constexpr int I_IN = 64 * 400, I_OUT = 64 * 128, I_G = 64 * 344, I_DN = 172 * 128, I_LAYER = I_IN + I_OUT + 2 * I_G + I_DN;
constexpr int CONV_PER_WAVE = 12, CONV_UNIT = 8 * CONV_PER_WAVE, N_CONV_UNITS = (DEPTH * I_LAYER - I_IN + CONV_UNIT - 1) / CONV_UNIT;
struct ConvItem { const float* src; bf16* dst; int N, pitch; };
__device__ __forceinline__ ConvItem conv_decode(KArgs P, int it, int lane) {
    const int l = it / I_LAYER; int r = it % I_LAYER; const float* W; bf16* WT; int N, pitch, k0, n0, drow;
    if (r < I_IN) { const int kb = r / 400, nb = r % 400; W = P->in[6] + (size_t)l * DM * INC; N = INC; WT = (bf16*)(P->ws + WS_WIN + l * SZ_WIN); pitch = DM; k0 = 64 * kb; n0 = 32 * nb; drow = n0; }
    else if ((r -= I_IN) < I_OUT) { const int kb = r / 128, nb = r % 128; W = P->in[7] + (size_t)l * DM * DM; N = DM; WT = (bf16*)(P->ws + WS_WOUT + l * SZ_WOUT); pitch = DM; k0 = 64 * kb; n0 = 32 * nb; drow = n0; }
    else if ((r -= I_OUT) < 2 * I_G) { const int up = r >= I_G; if (up) r -= I_G; const int kb = r / 344, nb = r % 344; n0 = 32 * nb;
        W = (up ? P->in[17] : P->in[16]) + (size_t)l * DM * DFF; N = DFF; WT = (bf16*)(P->ws + WS_WGU + l * SZ_WGU); pitch = DM; k0 = 64 * kb; drow = (n0 >> 7) * 256 + (n0 & 127) + (up ? 128 : 0); }
    else { r -= 2 * I_G; const int kb = r / 128, nb = r % 128; W = P->in[18] + (size_t)l * DFF * DM; N = DM; WT = (bf16*)(P->ws + WS_WDN + l * SZ_WDN); pitch = DFF; k0 = 64 * kb; n0 = 32 * nb; drow = n0; }
    ConvItem c; c.src = W + (size_t)(k0 + (lane >> 5)) * N + n0 + (lane & 31); c.dst = WT + (size_t)drow * pitch + k0; c.N = N; c.pitch = pitch; return c;
}
__device__ __forceinline__ void conv_load(float (&v)[32], const ConvItem& c) {
#pragma unroll
    for (int i = 0; i < 32; ++i) v[i] = __builtin_nontemporal_load(c.src + (size_t)(2 * i) * c.N);
}
__device__ __forceinline__ void conv_finish(const float (&v)[32], const ConvItem& c, LAS float* scr, int lane) {
#pragma unroll
    for (int i = 0; i < 32; ++i) scr[(2 * i + (lane >> 5)) * 33 + (lane & 31)] = v[i];
    LDS_WAIT(); asm volatile("" ::: "memory");
    const int cc = lane & 7;
#pragma unroll
    for (int j = 0; j < 4; ++j) { const int n = (lane >> 3) + 8 * j; const LAS float* s = scr + (8 * cc) * 33 + n;
        v4u o; o.x = pkbf(s[0 * 33], s[1 * 33]); o.y = pkbf(s[2 * 33], s[3 * 33]); o.z = pkbf(s[4 * 33], s[5 * 33]); o.w = pkbf(s[6 * 33], s[7 * 33]);
        __builtin_nontemporal_store(o, (GAS v4u*)(c.dst + (size_t)n * c.pitch + 8 * cc)); }
    LDS_WAIT(); asm volatile("" ::: "memory");
}
template <int NI> __device__ __forceinline__ void conv_run(KArgs P, int it0, int stride, int last, LAS float* scr, int lane) {
    float va[32], vb[32];
#define CONV_IT(k) (it0 + (k) * stride < last ? it0 + (k) * stride : last)
    ConvItem ca = conv_decode(P, CONV_IT(0), lane), cb = ca; conv_load(va, ca);
#pragma unroll 1
    for (int k = 0; k + 2 < NI; k += 2) {
        cb = conv_decode(P, CONV_IT(k + 1), lane); conv_load(vb, cb);
        conv_finish(va, ca, scr, lane);
        ca = conv_decode(P, CONV_IT(k + 2), lane); conv_load(va, ca);
        conv_finish(vb, cb, scr, lane);
    }
    if constexpr (NI % 2 == 0) { cb = conv_decode(P, CONV_IT(NI - 1), lane); conv_load(vb, cb); conv_finish(va, ca, scr, lane); conv_finish(vb, cb, scr, lane); }
    else conv_finish(va, ca, scr, lane);
#undef CONV_IT
}
__device__ __forceinline__ void p0_prologue(KArgs P, LAS unsigned char* lds, int gw, int NGW, int wave, int lane) {
    LAS float* scr = (LAS float*)(lds + wave * 16384);
    conv_run<13>(P, gw, NGW, I_IN - 1, scr, lane);
    for (int it = gw + 13 * NGW; it < I_IN; it += NGW) conv_run<1>(P, it, NGW, I_IN - 1, scr, lane);
    float* modp = (float*)(P->ws + WS_MODP);
    for (int it = gw; it < 2 * 96 * 16; it += NGW) {
        const int kp = it & 15, cb = (it >> 4) % 96, l = it / (16 * 96);
        f32x4 a0 = {0.f, 0.f, 0.f, 0.f}, a1 = a0, a2 = a0;
        const float* wb = P->in[4] + ((size_t)l * DM + 256 * kp) * 24576 + 256 * cb + 4 * lane;
        for (int kb = 0; kb < 4; ++kb) {
            const int k0 = 256 * kp + 64 * kb;
            const float s0 = silu_f(P->in[1][k0 + lane]), s1 = silu_f(P->in[1][DM + k0 + lane]), s2 = silu_f(P->in[3][k0 + lane]);
#pragma unroll 8
            for (int j = 0; j < 64; ++j) {
                const f32x4 w = *(const f32x4*)(wb + (size_t)(64 * kb + j) * 24576);
                a0 += w * bcast_lane(s0, j); a1 += w * bcast_lane(s1, j); a2 += w * bcast_lane(s2, j);
            }
        }
        float* o = modp + ((size_t)(kp * 2 + l) * 3) * 24576 + 256 * cb + 4 * lane;
        *(f32x4*)(o) = a0; *(f32x4*)(o + 24576) = a1; *(f32x4*)(o + 2 * 24576) = a2;
    }
}
__device__ __forceinline__ void p1_modreduce(KArgs P, int gtid, int NGT) {
    const float* modp = (const float*)(P->ws + WS_MODP); float* mod = (float*)(P->ws + WS_MOD);
    for (int i = gtid; i < 2 * 3 * 24576; i += NGT) {
        const int n = i % 24576, l = i / (3 * 24576);
        float s = P->in[5][l * 24576 + n];
#pragma unroll
        for (int kp = 0; kp < 16; ++kp) s += modp[(size_t)kp * (2 * 3 * 24576) + i];
        mod[i] = s;
    }
}
__device__ __forceinline__ void norm_phase(KArgs P, int l, int shift_idx, int scale_idx, int from_in, int skip_ctx, int add_parts, int gw, int ngw, int lane) {
    const bf16* xres = (const bf16*)(P->ws + WS_XRES); bf16* hx = (bf16*)(P->ws + WS_HX);
    const float* modl = (const float*)(P->ws + WS_MOD) + (size_t)l * 3 * 24576;
    for (int row = gw; row < MROWS; row += ngw) {
        const int b = row / ROWS_B, j = row % ROWS_B, rsel = (j < CTX) ? 2 : b;
        if (skip_ctx && j < CTX) continue;
        const f32x4* sh = (const f32x4*)(modl + rsel * 24576 + shift_idx * DM) + lane;
        const f32x4* sc = (const f32x4*)(modl + rsel * 24576 + scale_idx * DM) + lane;
        f32x4 v[16], sa1[8], sa0[8]; float ss = 0.f;
        if (from_in) { const float* src = (j < CTX) ? P->in[2] + ((size_t)b * CTX + j) * DM : P->in[0] + ((size_t)b * SEQ + (j - CTX)) * DM;
            const f32x4* xr = (const f32x4*)src + lane;
#pragma unroll
            for (int q = 0; q < 16; ++q) v[q] = xr[64 * q];
#pragma unroll
            for (int q = 0; q < 8; ++q) { sa1[q] = sc[64 * q]; sa0[q] = sh[64 * q]; } }
        else { const v2u* xb = (const v2u*)(xres + (size_t)row * DM) + lane; v2u t[16];
#pragma unroll
            for (int q = 0; q < 16; ++q) t[q] = xb[64 * q];
#pragma unroll
            for (int q = 0; q < 8; ++q) { sa1[q] = sc[64 * q]; sa0[q] = sh[64 * q]; }
#pragma unroll
            for (int q = 0; q < 16; ++q) v[q] = (f32x4){__uint_as_float(t[q].x << 16), __uint_as_float(t[q].x & 0xffff0000u), __uint_as_float(t[q].y << 16), __uint_as_float(t[q].y & 0xffff0000u)}; }
#pragma unroll
        for (int q = 0; q < 16; ++q) ss += (v[q].x * v[q].x + v[q].y * v[q].y) + (v[q].z * v[q].z + v[q].w * v[q].w);
        if (add_parts && j < CTX) {
            const f32x4* pp = (const f32x4*)(P->ws + WS_PART + ((size_t)(b * 256 + j) * DM) * 4) + lane; ss = 0.f;
#pragma unroll
            for (int q = 0; q < 16; ++q) { f32x4 t[8];
#pragma unroll
                for (int sl = 0; sl < 8; ++sl) t[sl] = pp[(size_t)sl * 512 * DM / 4 + 64 * q];
                f32x4 a = v[q];
#pragma unroll
                for (int sl = 0; sl < 8; ++sl) a += t[sl];
                v[q] = a; ss += (a.x * a.x + a.y * a.y) + (a.z * a.z + a.w * a.w); } }
        f32x4 sb1[8], sb0[8];
#pragma unroll
        for (int q = 0; q < 8; ++q) { sb1[q] = sc[64 * (q + 8)]; sb0[q] = sh[64 * (q + 8)]; }
        if ((from_in || add_parts) && j < CTX) { v2u* xo = (v2u*)(P->ws + WS_XRES + (size_t)row * DM * 2) + lane;
#pragma unroll
            for (int q = 0; q < 16; ++q) { v2u w; w.x = pkbf(v[q].x, v[q].y); w.y = pkbf(v[q].z, v[q].w); xo[64 * q] = w; } }
        const float rstd = __builtin_amdgcn_rsqf(wave_sum(ss) * (1.f / DM) + EPS);
        v2u* o = (v2u*)(hx + (size_t)row * DM) + lane;
#pragma unroll
        for (int q = 0; q < 8; ++q) { const f32x4 y = v[q] * rstd * (sa1[q] + 1.0f) + sa0[q];
            v2u w; w.x = pkbf(y.x, y.y); w.y = pkbf(y.z, y.w); o[64 * q] = w; }
#pragma unroll
        for (int q = 0; q < 8; ++q) { const f32x4 y = v[q + 8] * rstd * (sb1[q] + 1.0f) + sb0[q];
            v2u w; w.x = pkbf(y.x, y.y); w.y = pkbf(y.z, y.w); o[64 * (q + 8)] = w; }
    }
}
__device__ __forceinline__ void scanprep_phase(KArgs P, int l, int gtid, int NGT) {
    const bf16* qkv = (const bf16*)(P->ws + WS_QKV);
    bf16* QT = (bf16*)(P->ws + WS_QT); bf16* KT = (bf16*)(P->ws + WS_KT); bf16* KP = (bf16*)(P->ws + WS_KP); bf16* VT = (bf16*)(P->ws + WS_VT);
    float* DEC = (float*)(P->ws + WS_DEC);
    for (int idx = gtid; idx < NCHUNK * BW; idx += NGT) {
        const int ch = idx / BW, hd = idx % BW;
        float lbf = 0.f, lbb = 0.f;
        if (l > 0) { lbf = 1.f / (1.f + __expf(P->in[10][0 * 2 * BW + 0 * BW + hd] - P->in[10][1 * 2 * BW + 0 * BW + hd]));
                     lbb = 1.f / (1.f + __expf(P->in[10][0 * 2 * BW + 1 * BW + hd] - P->in[10][1 * 2 * BW + 1 * BW + hd])); }
        const bf16* base = qkv + (size_t)(ch * 16) * INC + hd;
        float q[16], gf[16], of[16], gb[16], ob[16]; unsigned short vv[16];
#pragma unroll
        for (int t = 0; t < 16; ++t) {
            const bf16* rp = base + (size_t)t * INC;
            q[t] = silu_f(bf2f(rp[C_BQ])); vv[t] = rp[C_BI];
            const float zf = bf2f(rp[C_BFF]), zb = bf2f(rp[C_BFB]);
            const float ef = __expf(-zf), sf = __builtin_amdgcn_rcpf(1.f + ef); gf[t] = __logf(lbf + (1.f - lbf) * sf); of[t] = (1.f - lbf) * ef * sf;
            const float eb = __expf(-zb), sb = __builtin_amdgcn_rcpf(1.f + eb); gb[t] = __logf(lbb + (1.f - lbb) * sb); ob[t] = (1.f - lbb) * eb * sb;
        }
        const int dl = hd & 31, pos = (hd & ~31) + 8 * ((dl >> 2) & 3) + 4 * (dl >> 4) + (dl & 3);
        { float b = 0.f; float bt[16];
#pragma unroll
          for (int t = 0; t < 16; ++t) { b += gf[t]; bt[t] = b; }
          unsigned kp[8];
#pragma unroll
          for (int t = 0; t < 16; ++t) { const float e = __expf(bt[t]);
              QT[(size_t)(ch * 16 + t) * BW + pos] = (bf16)(pkbf(q[t] * e, 0.f) & 0xffffu);
              KT[(size_t)(ch * 16 + t) * BW + pos] = (bf16)(pkbf(of[t] * __expf(-bt[t]), 0.f) & 0xffffu); }
#pragma unroll
          for (int t = 0; t < 16; t += 2) kp[t >> 1] = pkbf(of[t] * __expf(b - bt[t]), of[t + 1] * __expf(b - bt[t + 1]));
          v4u* o = (v4u*)(KP + ((size_t)ch * BW + hd) * 16); o[0] = (v4u){kp[0], kp[1], kp[2], kp[3]}; o[1] = (v4u){kp[4], kp[5], kp[6], kp[7]};
          DEC[(size_t)ch * BW + hd] = __expf(b); }
        { float b = 0.f; float bt[16];
#pragma unroll
          for (int t = 15; t >= 0; --t) { b += gb[t]; bt[t] = b; }
          unsigned kp[8];
          bf16* QTb = QT + (size_t)MROWS * BW; bf16* KTb = KT + (size_t)MROWS * BW;
#pragma unroll
          for (int t = 0; t < 16; ++t) { const float e = __expf(bt[t]);
              QTb[(size_t)(ch * 16 + t) * BW + pos] = (bf16)(pkbf(q[t] * e, 0.f) & 0xffffu);
              KTb[(size_t)(ch * 16 + t) * BW + pos] = (bf16)(pkbf(ob[t] * __expf(-bt[t]), 0.f) & 0xffffu); }
#pragma unroll
          for (int t = 0; t < 16; t += 2) kp[t >> 1] = pkbf(ob[t] * __expf(b - bt[t]), ob[t + 1] * __expf(b - bt[t + 1]));
          v4u* o = (v4u*)(KP + (size_t)MROWS * BW + ((size_t)ch * BW + hd) * 16); o[0] = (v4u){kp[0], kp[1], kp[2], kp[3]}; o[1] = (v4u){kp[4], kp[5], kp[6], kp[7]};
          DEC[(size_t)NCHUNK * BW + (size_t)ch * BW + hd] = __expf(b); }
        { v4u* o = (v4u*)(VT + ((size_t)ch * BW + hd) * 16);
          o[0] = (v4u){vv[0] | ((unsigned)vv[1] << 16), vv[2] | ((unsigned)vv[3] << 16), vv[4] | ((unsigned)vv[5] << 16), vv[6] | ((unsigned)vv[7] << 16)};
          o[1] = (v4u){vv[8] | ((unsigned)vv[9] << 16), vv[10] | ((unsigned)vv[11] << 16), vv[12] | ((unsigned)vv[13] << 16), vv[14] | ((unsigned)vv[15] << 16)}; }
    }
}
constexpr int SC_SLOT = 17408, SC_NSLOT = 4;
__device__ __forceinline__ void sc_glds16(const void* sbase, unsigned voff, unsigned lds_dst) { unsigned keep;
  asm volatile("s_mov_b32 %0, m0\n\ts_mov_b32 m0, %3\n\ts_nop 0\n\tglobal_load_lds_dwordx4 %1, %2\n\ts_mov_b32 m0, %0" : "=&s"(keep) : "v"(voff), "s"(sbase), "s"(lds_dst) : "memory"); }
__device__ __forceinline__ void sc_glds4(const void* sbase, unsigned voff, unsigned lds_dst) { unsigned keep;
  asm volatile("s_mov_b32 %0, m0\n\ts_mov_b32 m0, %3\n\ts_nop 0\n\tglobal_load_lds_dword %1, %2\n\ts_mov_b32 m0, %0" : "=&s"(keep) : "v"(voff), "s"(sbase), "s"(lds_dst) : "memory"); }
__device__ __forceinline__ void scan_unit(KArgs P, int chain, int wave, LAS unsigned char* ldsl) {
    const int lane = opaque_lane();
    const int b = chain / 20, h = (chain >> 1) % 10, dir = chain & 1;
    bf16* OB = (bf16*)(P->ws + WS_OB) + (size_t)dir * MROWS * BW;
    const int l16 = lane & 15, g = lane >> 4;
    const unsigned lds0 = (unsigned)(uintptr_t)ldsl;
    const int kind = wave >> 1, half = wave & 1;
    const char* src = (const char*)(P->ws + (kind == 0 ? WS_QT : kind == 1 ? WS_KT : kind == 2 ? WS_KP : WS_VT)) + (kind == 3 ? (size_t)0 : (size_t)dir * SZ_SC) + (kind < 2 ? h * 256 : h * 4096);
    unsigned voff[2];
#pragma unroll
    for (int i = 0; i < 2; ++i) { const int pr = 2 * half + i;
        if (kind < 2) { const int row = 4 * pr + (lane >> 4), logical = (lane & 15) ^ row; voff[i] = (unsigned)(row * (BW * 2) + logical * 16); }
        else voff[i] = (unsigned)(pr * 1024 + lane * 16); }
    const unsigned dst = lds0 + kind * 4096 + 2 * half * 1024, dstdec = lds0 + 16384 + half * 256;
    const char* srcdec = (const char*)(P->ws + WS_DEC) + ((size_t)dir * NCHUNK * BW + h * 128) * 4 + half * 256;
#define SC_CHUNK(ci) (b * 528 + (dir ? ((ci) < 16 ? 15 - (ci) : 543 - (ci)) : (ci)))
#define SC_DMA(ci, so) do { const int ch_ = SC_CHUNK(ci); const char* s_ = src + (size_t)ch_ * 40960; \
        sc_glds16(s_, voff[0], dst + (so)); sc_glds16(s_, voff[1], dst + (so) + 1024); sc_glds4(srcdec + (size_t)ch_ * 5120, (unsigned)lane * 4u, dstdec + (so)); } while (0)
#define SC_NEXT(so) ((so) == (SC_NSLOT - 1) * SC_SLOT ? 0 : (so) + SC_SLOT)
    const int a_qk = l16 * 256, a_kp = 8192 + l16 * 32 + 8 * g, a_vt = 12288 + (16 * wave + l16) * 32 + 8 * g, a_dec = 16384 + 16 * g;
    f32x4 S[8];
#pragma unroll
    for (int j = 0; j < 8; ++j) S[j] = (f32x4){0.f, 0.f, 0.f, 0.f};
    bool keep[4];
#pragma unroll
    for (int i = 0; i < 4; ++i) keep[i] = dir ? (4 * g + i >= l16) : (4 * g + i <= l16);
    SC_DMA(0, 0); SC_DMA(1, SC_SLOT); SC_DMA(2, 2 * SC_SLOT);
    int so = 0, so_n = 3 * SC_SLOT;
    for (int ci = 0; ci < 528; ++ci) {
        if (ci >= 3 && ci + 3 < 528) asm volatile("s_waitcnt vmcnt(18) lgkmcnt(0)\n\ts_barrier" ::: "memory");
        else asm volatile("s_waitcnt vmcnt(0) lgkmcnt(0)\n\ts_barrier" ::: "memory");
        if (ci + 3 < 528) SC_DMA(ci + 3, so_n);
        const LAS unsigned char* sb = ldsl + so;
        bf16x8 qf[4], kf[4]; s16x4 kp[8]; f32x4 dec[8];
#pragma unroll
        for (int j2 = 0; j2 < 4; ++j2) { const int co = ((4 * j2 + g) ^ l16) * 16; qf[j2] = *(const LAS bf16x8*)(sb + a_qk + co); kf[j2] = *(const LAS bf16x8*)(sb + 4096 + a_qk + co); }
#pragma unroll
        for (int j = 0; j < 8; ++j) { kp[j] = *(const LAS s16x4*)(sb + a_kp + 512 * j); dec[j] = *(const LAS f32x4*)(sb + a_dec + 64 * j); }
        const s16x4 vt = *(const LAS s16x4*)(sb + a_vt);
        const int ch = SC_CHUNK(ci);
        f32x4 pt = {0.f, 0.f, 0.f, 0.f};
#pragma unroll
        for (int j2 = 0; j2 < 4; ++j2) pt = __builtin_amdgcn_mfma_f32_16x16x32_bf16(kf[j2], qf[j2], pt, 0, 0, 0);
        v2u paw; paw.x = pkbf(keep[0] ? pt[0] : 0.f, keep[1] ? pt[1] : 0.f); paw.y = pkbf(keep[2] ? pt[2] : 0.f, keep[3] ? pt[3] : 0.f);
        const s16x4 pa = __builtin_bit_cast(s16x4, paw);
        const bf16x8 pa8 = {pa[0], pa[1], pa[2], pa[3], 0, 0, 0, 0}, vt8 = {vt[0], vt[1], vt[2], vt[3], 0, 0, 0, 0};
        f32x4 o = __builtin_amdgcn_mfma_f32_16x16x32_bf16(pa8, vt8, (f32x4){0.f, 0.f, 0.f, 0.f}, 0, 0, 0);
#pragma unroll
        for (int j2 = 0; j2 < 4; ++j2) {
            v4u sw; sw.x = pkbf(S[2 * j2][0], S[2 * j2][1]); sw.y = pkbf(S[2 * j2][2], S[2 * j2][3]); sw.z = pkbf(S[2 * j2 + 1][0], S[2 * j2 + 1][1]); sw.w = pkbf(S[2 * j2 + 1][2], S[2 * j2 + 1][3]);
            o = __builtin_amdgcn_mfma_f32_16x16x32_bf16(qf[j2], __builtin_bit_cast(bf16x8, sw), o, 0, 0, 0);
        }
#pragma unroll
        for (int j = 0; j < 8; ++j) { const bf16x8 kp8 = {kp[j][0], kp[j][1], kp[j][2], kp[j][3], 0, 0, 0, 0}; S[j] = __builtin_amdgcn_mfma_f32_16x16x32_bf16(kp8, vt8, S[j] * dec[j], 0, 0, 0); }
        bf16* op = OB + (size_t)(ch * 16 + 4 * g) * BW + h * 128 + 16 * wave + l16;
#pragma unroll
        for (int i = 0; i < 4; ++i) op[(size_t)i * BW] = (bf16)(pkbf(o[i], 0.f) & 0xffffu);
        so = SC_NEXT(so); so_n = SC_NEXT(so_n);
    }
#undef SC_CHUNK
#undef SC_DMA
#undef SC_NEXT
}
__device__ __forceinline__ void mixer_phase(KArgs P, int l, unsigned char* lds_generic, LAS unsigned char* ldsl, volatile LAS unsigned* MISC, gu32* ctl, int tid, int wave, int lane) {
    static_assert(DEPTH == 2, "conversion unit split");
    const int conv_first = l == 0 ? I_IN : I_LAYER + I_IN, conv_end = l == 0 ? I_LAYER + I_IN : DEPTH * I_LAYER;
    const int n_main = 40 + 768 + 1280, n_att = n_main + (l == 0 ? 64 : 0), total = n_att + (conv_end - conv_first + CONV_UNIT - 1) / CONV_UNIT;
    const bf16* qkv = (const bf16*)(P->ws + WS_QKV); bf16* mix = (bf16*)(P->ws + WS_MIX); bf16* oc = (bf16*)(P->ws + WS_OC);
    for (;;) {
        __syncthreads();
        if (wave == 0 && opaque_lane() == 0) MISC[4] = __hip_atomic_fetch_add((unsigned*)(ctl + CW_WQ + 64 * l), 1u, __ATOMIC_RELAXED, __HIP_MEMORY_SCOPE_AGENT);
        __syncthreads();
        const int u = __builtin_amdgcn_readfirstlane((int)MISC[4]);
        if (u >= total) break;
        if (u >= n_att) {
            LAS float* scr = (LAS float*)(ldsl + wave * 16384); const int ln = opaque_lane();
            conv_run<CONV_PER_WAVE>(P, conv_first + (u - n_att) * CONV_UNIT + wave, 8, conv_end - 1, scr, ln);
            continue; }
#ifndef ATT_SD
#define ATT_SD 1
#endif
#ifndef MIX_MASK
#define MIX_MASK 7
#endif
        if (u < 40) { if (MIX_MASK & 1) scan_unit(P, u, wave, ldsl); if (DBL & 1024) { __syncthreads(); scan_unit(P, u, wave, ldsl); __syncthreads(); scan_unit(P, u, wave, ldsl); } continue; }
        const bool isA = (u < 808) || (u >= n_main && u < n_main + 24);
        if (isA) {
            int hq, b, qrow; int seq;
            if (u < 808) { const int v = u - 40, g = v % 3, qb = (v / 3) & 31, kvh = (v / 96) & 3; b = v / 384; hq = kvh * 3 + g; qrow = CTX + 256 * qb; seq = ROWS_B; }
            else { const int v = u - n_main; hq = v % 12; b = v / 12; qrow = 0; seq = CTX; }
            const int kvh = hq / 3; const size_t rq = (size_t)b * ROWS_B + qrow, rk = (size_t)b * ROWS_B;
            if (MIX_MASK & 2) att::attn_body<128, false>(qkv + rq * INC + C_AQ + 128 * hq, qkv + rk * INC + C_AK + 128 * kvh, qkv + rk * INC + C_AV + 128 * kvh, mix + rq * DM + 128 * hq, DM, seq, (char*)lds_generic, wave);
        } else {
            int m, h, b, qrow; int seq;
            if (u < n_main) { const int v = u - 808; m = v & 1; const int qb = (v >> 1) & 31; h = (v >> 6) % 10; b = v / 640; qrow = CTX + 256 * qb; seq = ROWS_B; }
            else { const int v = u - n_main - 24; m = v & 1; h = (v >> 1) % 10; b = v / 20; qrow = 0; seq = CTX; }
            const size_t rq = (size_t)b * ROWS_B + qrow, rk = (size_t)b * ROWS_B;
            if (MIX_MASK & 4) att::attn_body<64, true>(qkv + rq * INC + C_CQ + 128 * h + 64 * m, qkv + rk * INC + C_CK + 128 * h + 64 * m, qkv + rk * INC + C_CV + 128 * h, oc + rq * 2560 + 128 * (2 * h + m), 2560, seq, (char*)lds_generic, wave);
        }
    }
}
__device__ __forceinline__ void finalize_phase(KArgs P, int l, int gw, int NGW, int lane) {
    const float lam_init = (l == 0) ? 0.2f : 0.35550906759f;
    const float* dl = P->in[14] + l * 256;
    const float lam = __expf(wave_sum(dl[lane] * dl[64 + lane])) - __expf(wave_sum(dl[128 + lane] * dl[192 + lane])) + lam_init;
    const f32x2 gdo = *(const f32x2*)(P->in[15] + l * 128 + 2 * lane), gho = *(const f32x2*)(P->in[11] + l * 128 + 2 * lane);
    const bf16* oc = (const bf16*)(P->ws + WS_OC); const bf16* obf = (const bf16*)(P->ws + WS_OB); const bf16* obb = obf + (size_t)MROWS * BW;
    const bf16* qkv = (const bf16*)(P->ws + WS_QKV); bf16* mix = (bf16*)(P->ws + WS_MIX);
    for (int row = gw; row < MROWS; row += NGW) {
        if (l == DEPTH - 1 && (row % ROWS_B) < CTX) continue;
        unsigned* mrow = (unsigned*)(mix + (size_t)row * DM);
        f32x2 c0[10], c1[10], bf_[10], bb_[10]; unsigned gt[10];
#pragma unroll
        for (int h = 0; h < 10; ++h) { const unsigned t0 = *(const unsigned*)(oc + (size_t)row * 2560 + 256 * h + 2 * lane), t1 = *(const unsigned*)(oc + (size_t)row * 2560 + 256 * h + 128 + 2 * lane);
            c0[h] = (f32x2){__uint_as_float(t0 << 16), __uint_as_float(t0 & 0xffff0000u)}; c1[h] = (f32x2){__uint_as_float(t1 << 16), __uint_as_float(t1 & 0xffff0000u)}; }
#pragma unroll
        for (int h = 0; h < 10; ++h) { const unsigned tf = *(const unsigned*)(obf + (size_t)row * BW + 128 * h + 2 * lane), tb = *(const unsigned*)(obb + (size_t)row * BW + 128 * h + 2 * lane);
            bf_[h] = (f32x2){__uint_as_float(tf << 16), __uint_as_float(tf & 0xffff0000u)}; bb_[h] = (f32x2){__uint_as_float(tb << 16), __uint_as_float(tb & 0xffff0000u)};
            gt[h] = *(const unsigned*)(qkv + (size_t)row * INC + C_BG + 128 * h + 2 * lane); }
#pragma unroll
        for (int h = 0; h < 10; ++h) {
            const f32x2 d = c0[h] - c1[h] * lam;
            const float r = __builtin_amdgcn_rsqf(wave_sum(d.x * d.x + d.y * d.y) * (1.f / 128.f) + EPS) * (1.0f - lam_init);
            mrow[(2816 + 128 * h) / 2 + lane] = pkbf(d.x * r * gdo.x, d.y * r * gdo.y);
        }
#pragma unroll
        for (int h = 0; h < 10; ++h) {
            const f32x2 a = bf_[h] + bb_[h];
            const float r = __builtin_amdgcn_rsqf(wave_sum(a.x * a.x + a.y * a.y) * (1.f / 128.f) + EPS);
            mrow[(1536 + 128 * h) / 2 + lane] = pkbf(a.x * r * gho.x * silu_f(bflo(gt[h])), a.y * r * gho.y * silu_f(bfhi(gt[h])));
        }
    }
}
__global__ void __launch_bounds__(NTHR, 2) hybrid_fwd(Args args) {
    extern __shared__ __attribute__((aligned(16))) unsigned char lds[];
    LAS unsigned char* ldsl = (LAS unsigned char*)lds;
    volatile LAS unsigned* MISC = (volatile LAS unsigned*)(ldsl + MISC_OFF);
    const int G = gridDim.x, bx = blockIdx.x;
    const int wave_s = __builtin_amdgcn_readfirstlane((int)(threadIdx.x >> 6));
#define PH_IDS const int lane = opaque_lane(), wave = opaque_s(wave_s), tid = wave * 64 + lane; (void)tid; (void)lane; (void)wave; const int lq = opaque_s(l); (void)lq;
#define GW (bx * NWAVES + wave)
#define NGW (G * NWAVES)
#define GTID (bx * NTHR + tid)
#define NGT (G * NTHR)
    for (int u = threadIdx.x; u < (LDS_BYTES - RING_BYTES) / 4; u += NTHR) ((LAS unsigned*)(ldsl + RING_BYTES))[u] = 0u;
    __syncthreads();
    const int lo = args.ph_lo, hi = args.ph_hi;
    XcdBarrier bar; bar.bar = (unsigned*)(args.ws + WS_CTL) + CW_BAR; bar.x = 0; bar.st = nullptr;
    if (hi - lo > 1) bar = xcd_barrier_post((unsigned*)(args.ws + WS_CTL) + CW_BAR, MISC + 8);
#ifndef PH_MASK
#define PH_MASK 0xFFFFFFFFu
#endif
#define IN(k) (lo <= (k) && (k) < hi)
#define EN(k) ((PH_MASK >> (k)) & 1u)
#define SEAM(k) do { if (IN(k) && IN((k) + 1)) xcd_barrier(bar); } while (0)

    if (EN(0) && IN(0)) { const int l = 0; PH_IDS p0_prologue(fresh_args(), ldsl, GW, NGW, wave, lane); if (DBL & 17) { __syncthreads(); p0_prologue(fresh_args(), ldsl, GW, NGW, wave, lane); } } SEAM(0);
    if (EN(1) && IN(1)) { const int l = 0; PH_IDS p1_modreduce(fresh_args(), GTID, NGT); } SEAM(1);

#pragma unroll
    for (int l = 0; l < DEPTH; ++l) {
        const int pb = 2 + 9 * l;
        if (EN(2) && IN(pb + 0)) { PH_IDS norm_phase(fresh_args(), lq, 0, 1, lq == 0, 0, lq > 0, GW, NGW, lane); if (DBL & 33) norm_phase(fresh_args(), lq, 0, 1, lq == 0, 0, lq > 0, GW, NGW, lane); } SEAM(pb + 0);
        if (EN(3) && IN(pb + 1)) {
            const int lq = opaque_s(l); KArgs P = fresh_args(); unsigned char* ws = P->ws;
            pg8::Gemm g{(const pg8::bf16_t*)(ws + WS_HX), (const pg8::bf16_t*)(ws + WS_WIN + lq * SZ_WIN), MROWS, INC, DM}; pg8::PanelOrder S; S.init(INC, G, bx, lq == DEPTH - 1, lq == DEPTH - 1 ? 58 : 0, 0, 0, WGM_IN);
            pg8::EpiInproj E{(pg8::bf16_t*)(ws + WS_QKV), INC, P->in[8] + lq * 128, P->in[9] + lq * 128, P->in[12] + lq * 64, P->in[13] + lq * 64, (LAS float*)(ldsl + RING_BYTES + 2048)};
            pg8::gemm_phase<pg8::EpiInproj, pg8::PanelOrder, true, true>(ldsl, g, S, E, opaque_s(wave_s));
            if (DBL & 2) { __syncthreads(); pg8::gemm_phase<pg8::EpiInproj, pg8::PanelOrder, true, true>(ldsl, g, S, E, opaque_s(wave_s)); }
        } SEAM(pb + 1);
        if (EN(4) && IN(pb + 2)) { PH_IDS scanprep_phase(fresh_args(), lq, GTID, NGT); if (DBL & 65) scanprep_phase(fresh_args(), lq, GTID, NGT); } SEAM(pb + 2);
        if (EN(5) && IN(pb + 3)) { PH_IDS KArgs P = fresh_args(); mixer_phase(P, lq, lds, ldsl, MISC, (gu32*)(P->ws + WS_CTL), tid, wave, lane); if (DBL & 4) { __syncthreads(); mixer_phase(P, lq, lds, ldsl, MISC, (gu32*)(P->ws + WS_CTL) + 2048, tid, wave, lane); } } SEAM(pb + 3);
        if (EN(6) && IN(pb + 4)) { PH_IDS finalize_phase(fresh_args(), lq, GW, NGW, lane); if (DBL & 129) finalize_phase(fresh_args(), lq, GW, NGW, lane); } SEAM(pb + 4);
        if (EN(7) && IN(pb + 5)) {
            const int lq = opaque_s(l); KArgs P = fresh_args(); unsigned char* ws = P->ws; float* xres = (float*)(ws + WS_XRES);
            pg8::Gemm g{(const pg8::bf16_t*)(ws + WS_MIX), (const pg8::bf16_t*)(ws + WS_WOUT + lq * SZ_WOUT), MROWS, DM, DM}; pg8::PanelOrder S; S.init(DM, G, bx, 1, 0, lq != DEPTH - 1, DM / 64, WGM_OUT);
            pg8::EpiResGate E{xres, xres, (const float*)(ws + WS_MOD) + (size_t)lq * 3 * 24576, 2 * DM, 0, lq == 0, P->in[0], P->in[2], (float*)(ws + WS_PART)};
            if (DBL & 256) { pg8::EpiResGate E2 = E; E2.out = (float*)(ws + WS_OC); pg8::gemm_phase<pg8::EpiResGate, pg8::PanelOrder, true, true>(ldsl, g, S, E2, opaque_s(wave_s)); __syncthreads(); }
            pg8::gemm_phase<pg8::EpiResGate, pg8::PanelOrder, true, true>(ldsl, g, S, E, opaque_s(wave_s));
        } SEAM(pb + 5);
        if (EN(8) && IN(pb + 6)) { PH_IDS norm_phase(fresh_args(), lq, 3, 4, 0, lq == DEPTH - 1, lq < DEPTH - 1, GW, NGW, lane); if (DBL & 33) norm_phase(fresh_args(), lq, 3, 4, 0, lq == DEPTH - 1, lq < DEPTH - 1, GW, NGW, lane); } SEAM(pb + 6);
        if (EN(9) && IN(pb + 7)) {
            const int lq = opaque_s(l); KArgs P = fresh_args(); unsigned char* ws = P->ws;
            pg8::Gemm g{(const pg8::bf16_t*)(ws + WS_HX), (const pg8::bf16_t*)(ws + WS_WGU + lq * SZ_WGU), MROWS, 2 * DFF, DM}; pg8::PanelOrder S; S.init(2 * DFF, G, bx, lq == DEPTH - 1, 0, 0, 0, WGM_GU);
            pg8::EpiSwiglu E{(pg8::bf16_t*)(ws + WS_QKV), DFF};
            pg8::gemm_phase<pg8::EpiSwiglu, pg8::PanelOrder, true, true>(ldsl, g, S, E, opaque_s(wave_s));
            if (DBL & 8) { __syncthreads(); pg8::gemm_phase<pg8::EpiSwiglu, pg8::PanelOrder, true, true>(ldsl, g, S, E, opaque_s(wave_s)); }
        } SEAM(pb + 7);
        if (EN(10) && IN(pb + 8)) {
            const int lq = opaque_s(l); KArgs P = fresh_args(); unsigned char* ws = P->ws; float* xres = (float*)(ws + WS_XRES);
            pg8::Gemm g{(const pg8::bf16_t*)(ws + WS_QKV), (const pg8::bf16_t*)(ws + WS_WDN + lq * SZ_WDN), MROWS, DM, DFF}; pg8::PanelOrder S; S.init(DM, G, bx, 1, 0, lq != DEPTH - 1, DFF / 64, WGM_DN);
            pg8::EpiResGate E{xres, (lq == DEPTH - 1) ? P->out : xres, (const float*)(ws + WS_MOD) + (size_t)lq * 3 * 24576, 5 * DM, (lq == DEPTH - 1) ? 1 : 0, 0, nullptr, nullptr, (float*)(ws + WS_PART)};
            if (DBL & 512) { pg8::EpiResGate E2 = E; E2.out = (float*)(ws + WS_OC); E2.final_out = 0; pg8::gemm_phase<pg8::EpiResGate, pg8::PanelOrder, true, true>(ldsl, g, S, E2, opaque_s(wave_s)); __syncthreads(); }
            pg8::gemm_phase<pg8::EpiResGate, pg8::PanelOrder, true, true>(ldsl, g, S, E, opaque_s(wave_s));
        } SEAM(pb + 8);
    }
#undef IN
#undef SEAM
}

extern "C" void kernel_launch(void* const* d_in, const int* in_sizes, int n_in, void* d_out, int out_size, void* d_ws, size_t ws_size, hipStream_t stream) {
    static int grid = 0;
    if (grid == 0) {
        if (n_in != 19 || out_size != NB * SEQ * DM || ws_size < WS_END) { fprintf(stderr, "kernel_launch: shape/workspace mismatch: n_in %d out %d ws %zu (need %zu)\n", n_in, out_size, ws_size, (size_t)WS_END); grid = -1; return; }
        int dev = 0, cus = 0, per_cu = 0;
        if (hipGetDevice(&dev) != hipSuccess || hipDeviceGetAttribute(&cus, hipDeviceAttributeMultiprocessorCount, dev) != hipSuccess) { grid = -1; return; }
        if (hipFuncSetAttribute((const void*)hybrid_fwd, hipFuncAttributeMaxDynamicSharedMemorySize, LDS_BYTES) != hipSuccess) { fprintf(stderr, "kernel_launch: hipFuncSetAttribute failed\n"); grid = -1; return; }
        if (hipOccupancyMaxActiveBlocksPerMultiprocessor(&per_cu, (const void*)hybrid_fwd, NTHR, LDS_BYTES) != hipSuccess || per_cu < 1) { fprintf(stderr, "kernel_launch: occupancy query says %d\n", per_cu); }
        (void)hipGetLastError();
        grid = cus;
    }
    if (grid < 0) return;
    if (hipMemsetAsync((char*)d_ws + WS_CTL, 0, CTL_ZERO_BYTES, stream) != hipSuccess) return;
    Args a{};
    for (int i = 0; i < 19; ++i) a.in[i] = (const float*)d_in[i];
    a.out = (float*)d_out; a.ws = (unsigned char*)d_ws;
#if MK_ONE_LAUNCH
    a.ph_lo = 0; a.ph_hi = N_PHASES;
    hipLaunchKernelGGL(hybrid_fwd, dim3(grid), dim3(NTHR), LDS_BYTES, stream, a);
#else
    for (int p = 0; p < N_PHASES; ++p) { a.ph_lo = p; a.ph_hi = p + 1; hipLaunchKernelGGL(hybrid_fwd, dim3(grid), dim3(NTHR), LDS_BYTES, stream, a); }
#endif
}
```

```cpp
#include <hip/hip_runtime.h>
#include <cstdio>
#include <cstdint>
__device__ __forceinline__ int opaque_lane() { int t = __builtin_amdgcn_mbcnt_hi(~0u, __builtin_amdgcn_mbcnt_lo(~0u, 0u)); asm volatile("" : "+v"(t)); return t; }
__device__ __forceinline__ int opaque_s(int v) { asm volatile("" : "+s"(v)); return v; }
namespace pg8 {
#define PG8_LAS __attribute__((address_space(3)))
typedef unsigned short bf16_t;
typedef short bf16x8 __attribute__((ext_vector_type(8)));
typedef float f32x4 __attribute__((ext_vector_type(4)));
typedef unsigned u32x4 __attribute__((ext_vector_type(4)));
constexpr int BM = 256, BK = 64, HALF = 128, HTB = HALF * BK * 2  , STAGE_BYTES = 8 * HTB, NXCD = 8, WGM = 8;

__host__ __device__ __forceinline__ int lds_byte(int r, int c) { const int st = (r >> 4) * 2 + (c >> 5), rr = r & 15, cc = c & 31, ob = rr * 64 + cc * 2; return st * 1024 + (ob ^ (((ob >> 9) & 1) << 5)); }
__host__ __device__ __forceinline__ void stage_rc(int b, int& R, int& C) { const int st = b / 1024, sb = b % 1024, swz = sb ^ (((sb >> 9) & 1) << 5); R = (st >> 1) * 16 + swz / 64; C = (st & 1) * 32 + (swz % 64) / 2; }
__host__ __device__ __forceinline__ int perm32(int rho) { const int n = rho >> 4, i = rho & 15; return 8 * (i >> 2) + 4 * n + (i & 3); }

struct Unit { int pm, pn, kt0, nt, sl; };
struct Gemm { const bf16_t* A; const bf16_t* Bt; int M, N, K; };

struct StaticOrder {
    int nM, nN, nwg, G, c, wgm;
    __host__ __device__ void init(int M, int N, int G_, int c_, int wgm_ = WGM) { nM = M / BM; nN = N / BM; nwg = nM * nN; G = G_; c = c_; wgm = wgm_; }
    __host__ __device__ bool next(int i, Unit& u) const {
        const long L = (long)i * G + c; if (L >= nwg) return false;
        int wgid = (int)L; { const int q = nwg / NXCD, r = nwg % NXCD, xcd = wgid % NXCD, off = wgid / NXCD; wgid = (xcd < r ? xcd * (q + 1) : r * (q + 1) + (xcd - r) * q) + off; }
        const int nig = wgm * nN, gid = wgid / nig, fm = gid * wgm, gsz = (nM - fm) < wgm ? (nM - fm) : wgm;
        u.pm = fm + ((wgid % nig) % gsz); u.pn = (wgid % nig) / gsz; u.kt0 = 0; u.nt = 0; u.sl = 0; return true;
    }
    __device__ __forceinline__ void a_ready(const Unit&) const {}
    __device__ __forceinline__ void done(const Unit&) const {}
};
struct PanelOrder {
    StaticOrder so; int skip, extra, slices, ktiles;
    __host__ __device__ void init(int N, int G_, int c_, int skip_, int extra_, int slices_ = 0, int ktiles_ = 0, int wgm_ = WGM) { skip = skip_; extra = extra_; slices = slices_; ktiles = ktiles_; so.init(skip_ ? 16384 : 16896, N, G_, c_, wgm_); }
    __host__ __device__ bool next(int i, Unit& u) const {
        if (so.next(i, u)) { if (skip) u.pm += 1 + (u.pm >= 32 ? 1 : 0); return true; }
        const long L = (long)i * so.G + so.c - so.nwg;
        if (slices) { if (L >= 2 * so.nN * 8) return false;
            const int tl = (int)(L >> 3), sl = (int)(L & 7); u.pm = (tl >= so.nN) ? 33 : 0; u.pn = tl % so.nN;
            const int base = (ktiles / 16) * 2, rem = (ktiles - base * 8) / 2;
            u.nt = base + (sl < rem ? 2 : 0); u.kt0 = sl * base + 2 * (sl < rem ? sl : rem); u.sl = sl; return true; }
        if (L >= extra) return false;
        u.pm = (L >= 29) ? 33 : 0; u.pn = 21 + (int)(L % 29); u.kt0 = 0; u.nt = 0; u.sl = 0; return true;
    }
    __device__ __forceinline__ void a_ready(const Unit&) const {}
    __device__ __forceinline__ void done(const Unit&) const {}
};

typedef float f32x2 __attribute__((ext_vector_type(2)));
typedef __bf16 bf16x2_c __attribute__((ext_vector_type(2)));
__device__ __forceinline__ unsigned cvt_pk_bf16(float lo, float hi) { f32x2 v = {lo, hi}; bf16x2_c b = __builtin_convertvector(v, bf16x2_c); return __builtin_bit_cast(unsigned, b); }
constexpr int ROWS_B = 8448, PAN_B = 33;
struct EpiStore {
    static constexpr bool PERM = true, AFTER_DRAIN = false;
    bf16_t* O; int ldc;
    __device__ __forceinline__ void operator()(const f32x4 (&acc)[2][2][4][2], const Unit& u, int wr, int wc, int fr, int fq) const {
        const int row0 = u.pm * BM + wr * 64 + fr, col0 = u.pn * BM + wc * 32 + 8 * fq;
#pragma unroll
        for (int ai = 0; ai < 2; ++ai)
#pragma unroll
            for (int m = 0; m < 4; ++m) { bf16_t* rowp = O + (size_t)(row0 + ai * HALF + m * 16) * ldc + col0;
#pragma unroll
                for (int bj = 0; bj < 2; ++bj) { const f32x4 v0 = acc[ai][bj][m][0], v1 = acc[ai][bj][m][1];
                    u32x4 w; w.x = cvt_pk_bf16(v0[0], v0[1]); w.y = cvt_pk_bf16(v0[2], v0[3]); w.z = cvt_pk_bf16(v1[0], v1[1]); w.w = cvt_pk_bf16(v1[2], v1[3]);
                    *(u32x4*)(rowp + bj * HALF) = w; } }
    }
};
struct EpiInproj {
    static constexpr bool PERM = true, AFTER_DRAIN = false;
    bf16_t* O; int ldc; const float* aq_g; const float* ak_g; const float* dq_g; const float* dk_g; PG8_LAS float* xs;
    __device__ __forceinline__ void operator()(const f32x4 (&acc)[2][2][4][2], const Unit& u, int wr, int wc, int fr, int fq) const {
        const int row0 = u.pm * BM + wr * 64 + fr, col0 = u.pn * BM + wc * 32 + 8 * fq;
        const int pn = u.pn, kind = pn < 6 ? 1 : pn < 11 ? 2 : (pn == 21 || pn == 22) ? 3 : (pn >= 25 && pn < 30) ? 4 : 0;
        if (kind == 0) {
#pragma unroll
            for (int ai = 0; ai < 2; ++ai)
#pragma unroll
                for (int m = 0; m < 4; ++m) { bf16_t* rowp = O + (size_t)(row0 + ai * HALF + m * 16) * ldc + col0;
#pragma unroll
                    for (int bj = 0; bj < 2; ++bj) { const f32x4 v0 = acc[ai][bj][m][0], v1 = acc[ai][bj][m][1];
                        u32x4 w; w.x = cvt_pk_bf16(v0[0], v0[1]); w.y = cvt_pk_bf16(v0[2], v0[3]); w.z = cvt_pk_bf16(v1[0], v1[1]); w.w = cvt_pk_bf16(v1[2], v1[3]);
                        *(u32x4*)(rowp + bj * HALF) = w; } }
            return;
        }
        const bool isA = (kind & 1) != 0, isq = kind <= 2;
#pragma unroll
        for (int ai = 0; ai < 2; ++ai)
#pragma unroll
            for (int m = 0; m < 4; ++m)
#pragma unroll
                for (int bj = 0; bj < 2; ++bj) { const f32x4 a = acc[ai][bj][m][0], c = acc[ai][bj][m][1];
                    float q = (a[0] * a[0] + a[1] * a[1]) + (a[2] * a[2] + a[3] * a[3]) + (c[0] * c[0] + c[1] * c[1]) + (c[2] * c[2] + c[3] * c[3]);
                    q += __int_as_float(__builtin_amdgcn_ds_swizzle(__float_as_int(q), 0x1f | (16 << 10)));
                    { auto rr = __builtin_amdgcn_permlane32_swap(__float_as_uint(q), __float_as_uint(q), false, false); q = __uint_as_float(rr[0]) + __uint_as_float(rr[1]); }
                    if (fq == 0) xs[((((wr * 2 + ai) * 4 + m) * 16 + fr) * 2 + bj) * 4 + wc] = q; }
        asm volatile("s_waitcnt lgkmcnt(0)\n\ts_barrier" ::: "memory");
        const float* gp = kind == 1 ? aq_g : kind == 3 ? ak_g : kind == 2 ? dq_g : dk_g;
        const int ch = isA ? (32 * wc + 8 * fq) : ((32 * wc + 8 * fq) & 63);
        const f32x4 g0 = *(const f32x4*)(gp + ch), g1 = *(const f32x4*)(gp + ch + 4);
        const float qs = isq ? (isA ? 0.12751743f : 0.18033688f) : 1.0f;
        const bool latent = (u.pm % PAN_B) != 0;
        const bool use_row = isA ? (wc < 2) : ((wc & 1) == 0);
        float inv[4];
#pragma unroll
        for (int k = 0; k < 4; ++k) { const int p = ch / 2 + k;
            inv[k] = isA ? __builtin_amdgcn_exp2f(-(float)(2 * (p & 31)) * (13.287712379549449f / 64.0f)) : __builtin_amdgcn_exp2f(-(float)(2 * (p & 15)) * (13.287712379549449f / 32.0f)); }
#pragma unroll
        for (int ai = 0; ai < 2; ++ai)
#pragma unroll
            for (int m = 0; m < 4; ++m) {
                const int row = row0 + ai * HALF + m * 16, t = row % ROWS_B - 256;
                float cs[4], sn[4];
#pragma unroll
                for (int k = 0; k < 4; ++k) { cs[k] = 1.f; sn[k] = 0.f; }
                if (latent) { const float pos = (float)(use_row ? (t >> 6) : (t & 63));
#pragma unroll
                    for (int k = 0; k < 4; ++k) { float rv = pos * inv[k] * 0.15915494309189535f; rv -= floorf(rv); cs[k] = __builtin_amdgcn_cosf(rv); sn[k] = __builtin_amdgcn_sinf(rv); } }
                bf16_t* rowp = O + (size_t)row * ldc + col0;
#pragma unroll
                for (int bj = 0; bj < 2; ++bj) {
                    const f32x4 t4 = *(const PG8_LAS f32x4*)(xs + ((((wr * 2 + ai) * 4 + m) * 16 + fr) * 2 + bj) * 4);
                    const float ssum = isA ? ((t4[0] + t4[1]) + (t4[2] + t4[3])) : (wc < 2 ? t4[0] + t4[1] : t4[2] + t4[3]);
                    const float rstd = __builtin_amdgcn_rsqf(ssum * (isA ? 1.f / 128.f : 1.f / 64.f) + 1e-6f) * qs;
                    const f32x4 y0 = acc[ai][bj][m][0] * g0 * rstd, y1 = acc[ai][bj][m][1] * g1 * rstd;
                    u32x4 w;
                    w.x = cvt_pk_bf16(y0[0] * cs[0] - y0[1] * sn[0], y0[0] * sn[0] + y0[1] * cs[0]); w.y = cvt_pk_bf16(y0[2] * cs[1] - y0[3] * sn[1], y0[2] * sn[1] + y0[3] * cs[1]);
                    w.z = cvt_pk_bf16(y1[0] * cs[2] - y1[1] * sn[2], y1[0] * sn[2] + y1[1] * cs[2]); w.w = cvt_pk_bf16(y1[2] * cs[3] - y1[3] * sn[3], y1[2] * sn[3] + y1[3] * cs[3]);
                    *(u32x4*)(rowp + bj * HALF) = w; }
            }
    }
};
struct EpiSwiglu {
    static constexpr bool PERM = true, AFTER_DRAIN = false;
    bf16_t* O; int ldc;
    __device__ __forceinline__ void operator()(const f32x4 (&acc)[2][2][4][2], const Unit& u, int wr, int wc, int fr, int fq) const {
        const int row0 = u.pm * BM + wr * 64 + fr, col0 = u.pn * HALF + wc * 32 + 8 * fq;
#pragma unroll
        for (int ai = 0; ai < 2; ++ai)
#pragma unroll
            for (int m = 0; m < 4; ++m) { bf16_t* rowp = O + (size_t)(row0 + ai * HALF + m * 16) * ldc + col0;
                float h[8];
#pragma unroll
                for (int n = 0; n < 2; ++n)
#pragma unroll
                    for (int i = 0; i < 4; ++i) { const float g = acc[ai][0][m][n][i], up = acc[ai][1][m][n][i];
                        h[n * 4 + i] = g * __builtin_amdgcn_rcpf(1.0f + __expf(-g)) * up; }
                u32x4 w; w.x = cvt_pk_bf16(h[0], h[1]); w.y = cvt_pk_bf16(h[2], h[3]); w.z = cvt_pk_bf16(h[4], h[5]); w.w = cvt_pk_bf16(h[6], h[7]);
                *(u32x4*)rowp = w; }
    }
};
typedef unsigned u32x2_e __attribute__((ext_vector_type(2)));
struct EpiResGate {
    static constexpr bool PERM = false, AFTER_DRAIN = false;
    const float* res; float* out; const float* modl; int goff; int final_out; int res_in; const float* xin; const float* cin; float* part;
    __device__ __forceinline__ void operator()(const f32x4 (&acc)[2][2][4][2], const Unit& u, int wr, int wc, int fr, int fq) const {
        const int b = u.pm / PAN_B, pl = u.pm % PAN_B, isctx = (pl == 0);
        if (final_out && isctx) return;
        const float* gate = modl + (isctx ? 2 : b) * 24576 + goff;
        const int col0 = u.pn * BM + wc * 32 + 4 * fq;
        f32x4 gv[2][2];
#pragma unroll
        for (int bj = 0; bj < 2; ++bj)
#pragma unroll
            for (int n = 0; n < 2; ++n) gv[bj][n] = *(const f32x4*)(gate + col0 + bj * HALF + n * 16);
        const float* rbase = isctx ? cin + (size_t)b * 256 * 4096 : xin + ((size_t)b * 8192 + (size_t)(pl - 1) * 256) * 4096;
        float* obase = out + ((size_t)b * 8192 + (size_t)(pl - 1) * 256) * 4096;
        const bf16_t* resb = (const bf16_t*)res + (size_t)u.pm * BM * 4096; bf16_t* outb = (bf16_t*)out + (size_t)u.pm * BM * 4096;
#define ERG_OFF(ai, m, bj, n) ((size_t)((ai) * HALF + wr * 64 + (m) * 16 + fr) * 4096 + col0 + (bj) * HALF + (n) * 16)
        if (u.nt) {
            float* pb = part + ((size_t)(u.sl * 512 + b * 256) * 4096);
#pragma unroll
            for (int ai = 0; ai < 2; ++ai)
#pragma unroll
                for (int m = 0; m < 4; ++m)
#pragma unroll
                    for (int bj = 0; bj < 2; ++bj)
#pragma unroll
                        for (int n = 0; n < 2; ++n) *(f32x4*)(pb + ERG_OFF(ai, m, bj, n)) = gv[bj][n] * acc[ai][bj][m][n];
            return;
        }
        if (res_in) {
#pragma unroll
            for (int ai = 0; ai < 2; ++ai)
#pragma unroll
                for (int mh = 0; mh < 2; ++mh) {
                    f32x4 x[2][2][2];
#pragma unroll
                    for (int m = 0; m < 2; ++m)
#pragma unroll
                        for (int bj = 0; bj < 2; ++bj)
#pragma unroll
                            for (int n = 0; n < 2; ++n) x[m][bj][n] = *(const f32x4*)(rbase + ERG_OFF(ai, 2 * mh + m, bj, n));
#pragma unroll
                    for (int m = 0; m < 2; ++m)
#pragma unroll
                        for (int bj = 0; bj < 2; ++bj)
#pragma unroll
                            for (int n = 0; n < 2; ++n) { const f32x4 y = x[m][bj][n] + gv[bj][n] * acc[ai][bj][2 * mh + m][n];
                                u32x2_e w; w.x = cvt_pk_bf16(y[0], y[1]); w.y = cvt_pk_bf16(y[2], y[3]); *(u32x2_e*)(outb + ERG_OFF(ai, 2 * mh + m, bj, n)) = w; }
                }
            return;
        }
        {
#pragma unroll
            for (int ai = 0; ai < 2; ++ai) {
                u32x2_e xb[4][2][2];
#pragma unroll
                for (int m = 0; m < 4; ++m)
#pragma unroll
                    for (int bj = 0; bj < 2; ++bj)
#pragma unroll
                        for (int n = 0; n < 2; ++n) xb[m][bj][n] = *(const u32x2_e*)(resb + ERG_OFF(ai, m, bj, n));
#pragma unroll
                for (int m = 0; m < 4; ++m)
#pragma unroll
                    for (int bj = 0; bj < 2; ++bj)
#pragma unroll
                        for (int n = 0; n < 2; ++n) { const u32x2_e t = xb[m][bj][n];
                            const f32x4 x = (f32x4){__uint_as_float(t.x << 16), __uint_as_float(t.x & 0xffff0000u), __uint_as_float(t.y << 16), __uint_as_float(t.y & 0xffff0000u)};
                            const f32x4 y = x + gv[bj][n] * acc[ai][bj][m][n];
                            if (final_out) *(f32x4*)(obase + ERG_OFF(ai, m, bj, n)) = y;
                            else { u32x2_e w; w.x = cvt_pk_bf16(y[0], y[1]); w.y = cvt_pk_bf16(y[2], y[3]); *(u32x2_e*)(outb + ERG_OFF(ai, m, bj, n)) = w; } }
            }
        }
#undef ERG_OFF
    }
};
template <class Epi, class Sched, bool ALIGN_EPI = false, bool SP2 = false>
__device__ __forceinline__ void gemm_phase(PG8_LAS unsigned char* lds, const Gemm g, const Sched& S, const Epi& E, const int wid) {
    const int lane = opaque_lane(), tid = wid * 64 + lane, wr = wid >> 2, wc = wid & 3, fr = lane & 15, fq = lane >> 4;
    const int K = g.K, nt = K / BK;
    unsigned voffA[2], voffB[2];
#pragma unroll
    for (int i = 0; i < 2; ++i) { int R, C; stage_rc(tid * 16 + i * 8192, R, C); const int Rb = Epi::PERM ? ((R & ~31) + perm32(R & 31)) : R;
        voffA[i] = (unsigned)(R * K + C) * 2u; voffB[i] = (unsigned)(Rb * K + C) * 2u; }
    const size_t kstep = (size_t)(BK * 2);
    const size_t hstep = (size_t)HALF * K * 2;
    const size_t tstep = 2 * hstep;
    const unsigned ldsw = (unsigned)wid * 1024u;
    const int aoff = lds_byte(wr * 64 + fr, fq * 8), boff = lds_byte(wc * 32 + fr, fq * 8);
#define PG8_SA(b, h) (((b) * 2 + (h)) * HTB)
#define PG8_SB(b, h) ((4 + (b) * 2 + (h)) * HTB)
#define PG8_STAGE(bufoff, gbase, voff) do { _Pragma("unroll") for (int _i = 0; _i < 2; ++_i) \
        __builtin_amdgcn_global_load_lds((const unsigned*)((const char*)(gbase) + (voff)[_i]), (PG8_LAS unsigned*)(lds + (bufoff) + ldsw + _i * 8192), 16, 0, 0); } while (0)
#define PG8_LDA(dst, b, h) do { _Pragma("unroll") for (int m = 0; m < 4; ++m) _Pragma("unroll") for (int k = 0; k < 2; ++k) dst[m][k] = *(const PG8_LAS bf16x8*)(lds + PG8_SA(b, h) + aoff + m * 2048 + k * 1024); } while (0)
#define PG8_LDB(dst, b, h) do { _Pragma("unroll") for (int n = 0; n < 2; ++n) _Pragma("unroll") for (int k = 0; k < 2; ++k) dst[n][k] = *(const PG8_LAS bf16x8*)(lds + PG8_SB(b, h) + boff + n * 2048 + k * 1024); } while (0)
#define PG8_MMA(ai, bj, At, Bt) do { __builtin_amdgcn_s_setprio(1); _Pragma("unroll") for (int m = 0; m < 4; ++m) _Pragma("unroll") for (int n = 0; n < 2; ++n) _Pragma("unroll") for (int k = 0; k < 2; ++k) \
        acc[ai][bj][m][n] = __builtin_amdgcn_mfma_f32_16x16x32_bf16(Bt[n][k], At[m][k], acc[ai][bj][m][n], 0, 0, 0); __builtin_amdgcn_s_setprio(0); } while (0)
#define PG8_WAIT_V(n) asm volatile("s_waitcnt vmcnt(" #n ")" ::: "memory")
#define PG8_WAIT_L(n) asm volatile("s_waitcnt lgkmcnt(" #n ")" ::: "memory")
#define PG8_BAR __builtin_amdgcn_s_barrier()
#define PG8_SCHED __builtin_amdgcn_sched_barrier(0)
    Unit cur, nxt; int ui = 0;
    if (!S.next(0, cur)) return;
    f32x4 acc[2][2][4][2];
#pragma unroll
    for (int a = 0; a < 2; ++a)
#pragma unroll
        for (int b = 0; b < 2; ++b)
#pragma unroll
            for (int m = 0; m < 4; ++m)
#pragma unroll
                for (int n = 0; n < 2; ++n) acc[a][b][m][n] = (f32x4){0.f, 0.f, 0.f, 0.f};
    bf16x8 At[4][2], B0[2][2], B1[2][2];
    const char* cA = (const char*)g.A + (size_t)cur.pm * tstep + (size_t)cur.kt0 * kstep; const char* cB = (const char*)g.Bt + (size_t)cur.pn * tstep + (size_t)cur.kt0 * kstep;
    int cnt = cur.nt ? cur.nt : nt;
    S.a_ready(cur);
    if constexpr (SP2) {
        PG8_STAGE(PG8_SB(0, 0), cB, voffB); PG8_STAGE(PG8_SB(0, 1), cB + hstep, voffB); PG8_STAGE(PG8_SA(0, 0), cA, voffA); PG8_STAGE(PG8_SA(0, 1), cA + hstep, voffA);
        if (wr == 1) PG8_BAR;
        PG8_WAIT_V(2); PG8_BAR;
        PG8_STAGE(PG8_SB(1, 0), cB + kstep, voffB); PG8_STAGE(PG8_SA(1, 0), cA + kstep, voffA); PG8_STAGE(PG8_SB(1, 1), cB + hstep + kstep, voffB);
        PG8_WAIT_V(6); PG8_BAR;
    } else {
        PG8_STAGE(PG8_SB(0, 0), cB, voffB); PG8_STAGE(PG8_SA(0, 0), cA, voffA); PG8_STAGE(PG8_SB(0, 1), cB + hstep, voffB); PG8_STAGE(PG8_SA(0, 1), cA + hstep, voffA);
        if (wr == 1) PG8_BAR;
        PG8_WAIT_V(4); PG8_BAR;
        PG8_STAGE(PG8_SB(1, 0), cB + kstep, voffB); PG8_STAGE(PG8_SA(1, 0), cA + kstep, voffA); PG8_STAGE(PG8_SB(1, 1), cB + hstep + kstep, voffB);
        PG8_WAIT_V(6); PG8_BAR;
    }
    for (;;) {
        const bool has_next = S.next(ui + 1, nxt);
        const char* nA = has_next ? (const char*)g.A + (size_t)nxt.pm * tstep + (size_t)nxt.kt0 * kstep : cA; const char* nB = has_next ? (const char*)g.Bt + (size_t)nxt.pn * tstep + (size_t)nxt.kt0 * kstep : cB;
        for (int t = 0; t < cnt; t += 2) {
            const bool last = (t == cnt - 2);
            const char* a1 = cA + (size_t)(t + 1) * kstep;
            const char* a2 = last ? nA : cA + (size_t)(t + 2) * kstep; const char* b2 = last ? nB : cB + (size_t)(t + 2) * kstep;
            const char* a3 = a2 + kstep; const char* b3 = b2 + kstep;
            if (last && has_next) S.a_ready(nxt);
            if constexpr (SP2) {
            PG8_LDB(B0, 0, 0); PG8_LDB(B1, 0, 1); PG8_SCHED; PG8_LDA(At, 0, 0); PG8_STAGE(PG8_SA(1, 1), a1 + hstep, voffA);
            PG8_WAIT_V(8); PG8_WAIT_L(0); PG8_BAR; PG8_MMA(0, 0, At, B0); PG8_MMA(0, 1, At, B1); PG8_BAR; PG8_SCHED;
            PG8_LDA(At, 0, 1); PG8_STAGE(PG8_SB(0, 0), b2, voffB); PG8_STAGE(PG8_SB(0, 1), b2 + hstep, voffB); PG8_STAGE(PG8_SA(0, 0), a2, voffA);
            PG8_WAIT_V(8); PG8_WAIT_L(0); PG8_BAR; PG8_MMA(1, 0, At, B0); PG8_MMA(1, 1, At, B1); PG8_BAR; PG8_SCHED;
            PG8_LDB(B0, 1, 0); PG8_LDB(B1, 1, 1); PG8_SCHED; PG8_LDA(At, 1, 0); PG8_STAGE(PG8_SA(0, 1), a2 + hstep, voffA);
            PG8_WAIT_V(8); PG8_WAIT_L(0); PG8_BAR; PG8_MMA(0, 0, At, B0); PG8_MMA(0, 1, At, B1); PG8_BAR; PG8_SCHED;
            PG8_LDA(At, 1, 1); PG8_STAGE(PG8_SB(1, 0), b3, voffB); PG8_STAGE(PG8_SB(1, 1), b3 + hstep, voffB); PG8_STAGE(PG8_SA(1, 0), a3, voffA);
            PG8_WAIT_V(8); PG8_WAIT_L(0); PG8_BAR; PG8_MMA(1, 0, At, B0); PG8_MMA(1, 1, At, B1); PG8_BAR; PG8_SCHED;
            } else {
            PG8_LDB(B0, 0, 0); PG8_SCHED; PG8_LDA(At, 0, 0); PG8_STAGE(PG8_SA(1, 1), a1 + hstep, voffA);
            PG8_WAIT_L(8); PG8_BAR; PG8_WAIT_L(0); PG8_MMA(0, 0, At, B0); PG8_BAR; PG8_SCHED;
            PG8_LDB(B1, 0, 1); PG8_STAGE(PG8_SB(0, 0), b2, voffB);
            PG8_BAR; PG8_WAIT_L(0); PG8_MMA(0, 1, At, B1); PG8_BAR;
            PG8_LDA(At, 0, 1); PG8_STAGE(PG8_SA(0, 0), a2, voffA);
            PG8_BAR; PG8_WAIT_L(0); PG8_MMA(1, 0, At, B0); PG8_BAR; PG8_SCHED;
            PG8_STAGE(PG8_SB(0, 1), b2 + hstep, voffB);
            PG8_WAIT_V(6); PG8_BAR; PG8_MMA(1, 1, At, B1); PG8_BAR;
            PG8_LDB(B0, 1, 0); PG8_SCHED; PG8_LDA(At, 1, 0); PG8_STAGE(PG8_SA(0, 1), a2 + hstep, voffA);
            PG8_WAIT_L(8); PG8_BAR; PG8_WAIT_L(0); PG8_MMA(0, 0, At, B0); PG8_BAR; PG8_SCHED;
            PG8_LDB(B1, 1, 1); PG8_STAGE(PG8_SB(1, 0), b3, voffB);
            PG8_BAR; PG8_WAIT_L(0); PG8_MMA(0, 1, At, B1); PG8_BAR;
            PG8_LDA(At, 1, 1); PG8_STAGE(PG8_SA(1, 0), a3, voffA);
            PG8_BAR; PG8_WAIT_L(0); PG8_MMA(1, 0, At, B0); PG8_BAR; PG8_SCHED;
            PG8_STAGE(PG8_SB(1, 1), b3 + hstep, voffB);
            PG8_WAIT_V(6); PG8_BAR; PG8_MMA(1, 1, At, B1); PG8_BAR;
            }
        }
        if constexpr (ALIGN_EPI) { if (wr == 0) PG8_BAR; }
        if constexpr (!Epi::AFTER_DRAIN) { E(acc, cur, wr, wc, fr, fq); S.done(cur); }
        if (!has_next) break;
#pragma unroll
        for (int a = 0; a < 2; ++a)
#pragma unroll
            for (int b = 0; b < 2; ++b)
#pragma unroll
                for (int m = 0; m < 4; ++m)
#pragma unroll
                    for (int n = 0; n < 2; ++n) acc[a][b][m][n] = (f32x4){0.f, 0.f, 0.f, 0.f};
        cur = nxt; cA = nA; cB = nB; ++ui; cnt = cur.nt ? cur.nt : nt;
        if constexpr (ALIGN_EPI) { if (wr == 1) PG8_BAR; }
    }
    PG8_WAIT_V(0);
    if constexpr (!ALIGN_EPI) { if (wr == 0) PG8_BAR; }
    PG8_BAR;
    if constexpr (Epi::AFTER_DRAIN) { E.fused(acc, cur, wr, wc, fr, fq, lds, wid, lane); S.done(cur); }
#undef PG8_SA
#undef PG8_SB
#undef PG8_STAGE
#undef PG8_LDA
#undef PG8_LDB
#undef PG8_MMA
#undef PG8_WAIT_V
#undef PG8_WAIT_L
#undef PG8_BAR
#undef PG8_SCHED
}
}
namespace att {
typedef unsigned short bf16_t;
using bf16x8 = __attribute__((ext_vector_type(8))) short;
using s16x4  = __attribute__((ext_vector_type(4))) short;
using f32x16 = __attribute__((ext_vector_type(16))) float;
using u32x4  = __attribute__((ext_vector_type(4))) unsigned;
constexpr int NW = 8, QBLK = 32, KVBLK = 64, LDX = 12800;
constexpr float THR = 8.f;
constexpr int SHM_V = KVBLK * 128 * 2, SHM_K = KVBLK * 128 * 2, SHM_ATTN = 2 * SHM_V + 2 * SHM_K + NW * 64 * 4;
#define ATT_SBAR() __builtin_amdgcn_sched_barrier(0)
__device__ __forceinline__ int crow(int r, int hi) { return (r & 3) + 8 * (r >> 2) + 4 * hi; }
__device__ __forceinline__ unsigned cvtpk(float lo, float hi) { unsigned r; asm volatile("v_cvt_pk_bf16_f32 %0, %1, %2" : "=v"(r) : "v"(lo), "v"(hi)); return r; }
template <int DQK> __device__ __forceinline__ int kswz(int row, int colB) {
  if constexpr (DQK == 128) return row * 256 + (colB ^ ((row & 7) << 4));
  else return (row >> 1) * 256 + ((((row & 1) << 7) + colB) ^ (((row >> 1) & 7) << 4));
}

__device__ __forceinline__ void partialSM(f32x16&) {}
__device__ __forceinline__ void finishSM(f32x16& p0, f32x16& p1, float& l_reg, bf16x8& pa0, bf16x8& pa1, bf16x8& pa2, bf16x8& pa3) {
#pragma unroll
  for (int r = 0; r < 16; ++r) p0[r] = __builtin_amdgcn_exp2f(p0[r]);
#pragma unroll
  for (int r = 0; r < 16; ++r) p1[r] = __builtin_amdgcn_exp2f(p1[r]);
  float ps = 0;
#pragma unroll
  for (int r = 0; r < 16; ++r) ps += p0[r];
#pragma unroll
  for (int r = 0; r < 16; ++r) ps += p1[r];
  l_reg += ps;
#define ATT_PK4(P, BASE, OUT) do { unsigned a0 = cvtpk(P[BASE + 0], P[BASE + 1]), a1 = cvtpk(P[BASE + 2], P[BASE + 3]);   \
    unsigned b0 = cvtpk(P[BASE + 4], P[BASE + 5]), b1 = cvtpk(P[BASE + 6], P[BASE + 7]);                              \
    auto r0 = __builtin_amdgcn_permlane32_swap(a0, b0, false, false); auto r1 = __builtin_amdgcn_permlane32_swap(a1, b1, false, false); \
    u32x4 w = {r0[0], r1[0], r0[1], r1[1]}; OUT = *reinterpret_cast<bf16x8*>(&w); } while (0)
  ATT_PK4(p0, 0, pa0); ATT_PK4(p0, 8, pa1); ATT_PK4(p1, 0, pa2); ATT_PK4(p1, 8, pa3);
#undef ATT_PK4
}
template <int DQK> __device__ __forceinline__ void qkt(f32x16& p0, f32x16& p1, const char* Ks, const bf16x8* qr, int r32, int hi) {
  constexpr int N = DQK / 16;
  bf16x8 k0[2], k1[2];
  { const int cb = (hi * 8) * 2; k0[0] = *reinterpret_cast<const bf16x8*>(Ks + kswz<DQK>(r32, cb)); k1[0] = *reinterpret_cast<const bf16x8*>(Ks + kswz<DQK>(32 + r32, cb)); }
  p0 = f32x16{}; p1 = f32x16{};
#pragma unroll
  for (int d0 = 0; d0 < N; ++d0) {
    if (d0 + 1 < N) { const int cb = ((d0 + 1) * 16 + hi * 8) * 2;
      k0[(d0 + 1) & 1] = *reinterpret_cast<const bf16x8*>(Ks + kswz<DQK>(r32, cb)); k1[(d0 + 1) & 1] = *reinterpret_cast<const bf16x8*>(Ks + kswz<DQK>(32 + r32, cb)); }
    __builtin_amdgcn_sched_barrier(0x406);
    p0 = __builtin_amdgcn_mfma_f32_32x32x16_bf16(k0[d0 & 1], qr[d0], p0, 0, 0, 0);
    p1 = __builtin_amdgcn_mfma_f32_32x32x16_bf16(k1[d0 & 1], qr[d0], p1, 0, 0, 0);
    __builtin_amdgcn_sched_barrier(0x406);
  }
}
__device__ __forceinline__ int v_st(int k, int c) { const int kk = (k & ~0xC) | ((k & 4) << 1) | ((k & 8) >> 1); return ((kk >> 3) * 4 + (c >> 5)) * 512 + ((kk & 7) * 32 + (c & 31)) * 2; }
__device__ __forceinline__ int v_rd_base(int lane) { return ((lane & 3) << 3) | (((lane >> 2) & 3) << 6) | (((lane >> 4) & 1) << 5) | (((lane >> 5) & 1) << 8); }
constexpr int v_rd_off(int d0, int ks, int half) { return d0 * 512 + ks * 4096 + half * 2048; }
template <int OFF> __device__ __forceinline__ s16x4 tr_read(int vb) {
  s16x4 r; asm volatile("ds_read_b64_tr_b16 %0, %1 offset:%2" : "=&v"(r) : "v"(vb), "i"(OFF) : "memory"); return r;
}
template <int D0> __device__ __forceinline__ void pv_one(f32x16& od, int vb, bf16x8 pa0, bf16x8 pa1, bf16x8 pa2, bf16x8 pa3) {
  const s16x4 l0 = tr_read<v_rd_off(D0, 0, 0)>(vb), h0 = tr_read<v_rd_off(D0, 0, 1)>(vb), l1 = tr_read<v_rd_off(D0, 1, 0)>(vb), h1 = tr_read<v_rd_off(D0, 1, 1)>(vb);
  const s16x4 l2 = tr_read<v_rd_off(D0, 2, 0)>(vb), h2 = tr_read<v_rd_off(D0, 2, 1)>(vb), l3 = tr_read<v_rd_off(D0, 3, 0)>(vb), h3 = tr_read<v_rd_off(D0, 3, 1)>(vb);
  asm volatile("s_waitcnt lgkmcnt(0)" ::: "memory"); ATT_SBAR();
#define ATT_PK(L, H) (bf16x8){L[0], L[1], L[2], L[3], H[0], H[1], H[2], H[3]}
  od = __builtin_amdgcn_mfma_f32_32x32x16_bf16(pa0, ATT_PK(l0, h0), od, 0, 0, 0);
  od = __builtin_amdgcn_mfma_f32_32x32x16_bf16(pa1, ATT_PK(l1, h1), od, 0, 0, 0);
  od = __builtin_amdgcn_mfma_f32_32x32x16_bf16(pa2, ATT_PK(l2, h2), od, 0, 0, 0);
  od = __builtin_amdgcn_mfma_f32_32x32x16_bf16(pa3, ATT_PK(l3, h3), od, 0, 0, 0);
#undef ATT_PK
}
__device__ __forceinline__ void pv_d0(f32x16* o, int vb, bf16x8 pa0, bf16x8 pa1, bf16x8 pa2, bf16x8 pa3) {
  pv_one<0>(o[0], vb, pa0, pa1, pa2, pa3); pv_one<1>(o[1], vb, pa0, pa1, pa2, pa3); pv_one<2>(o[2], vb, pa0, pa1, pa2, pa3); pv_one<3>(o[3], vb, pa0, pa1, pa2, pa3);
}

constexpr int SLOT = 32768, SLOT_V = 16384, NSLOT = 3, ATT_LDS = NSLOT * SLOT + NW * 64 * 4;
__device__ __forceinline__ void glds16(const void* sbase, unsigned voff, unsigned lds_dst) {
  unsigned keep;
  asm volatile("s_mov_b32 %0, m0\n\ts_mov_b32 m0, %3\n\ts_nop 0\n\tglobal_load_lds_dwordx4 %1, %2\n\ts_mov_b32 m0, %0" : "=&s"(keep) : "v"(voff), "s"(sbase), "s"(lds_dst) : "memory");
}
#define ATT_WAIT_BAR() asm volatile("s_waitcnt vmcnt(0) lgkmcnt(0)\n\ts_barrier" ::: "memory")
template <int DQK, bool OUTF32>
__device__ __forceinline__ void attn_body(const bf16_t* __restrict__ Qb, const bf16_t* __restrict__ Kh, const bf16_t* __restrict__ Vh,
                                          void* __restrict__ Ob, const int ldo, const int seq, char* lds, const int wid) {
  const int lane = opaque_lane(), r32 = lane & 31, hi = lane >> 5;
  const unsigned lds0 = (unsigned)(uintptr_t)lds;
  float* li_l = (float*)(lds + NSLOT * SLOT) + wid * 64;
  float l_reg = 0; f32x16 o[4] = {}; bf16x8 qr[DQK / 16];
  const bf16_t* Qw = Qb + (long)(wid * QBLK + r32) * LDX + hi * 8;
#pragma unroll
  for (int d0 = 0; d0 < DQK / 16; ++d0) qr[d0] = *reinterpret_cast<const bf16x8*>(Qw + d0 * 16);
  unsigned offK[2], offV[2];
  if constexpr (DQK == 128) {
#pragma unroll
    for (int i = 0; i < 2; ++i) { const int row = 4 * (2 * wid + i) + (lane >> 4), colB = ((lane & 15) * 16) ^ ((row & 7) << 4); offK[i] = (unsigned)(row * (LDX * 2) + colB); }
  } else {
    const int sr = 4 * wid + (lane >> 4), x = ((lane & 15) * 16) ^ ((sr & 7) << 4), row = 2 * sr + (x >> 7); offK[0] = (unsigned)(row * (LDX * 2) + (x & 127)); offK[1] = 0;
  }
#pragma unroll
  for (int i = 0; i < 2; ++i) { const int sub = 2 * (2 * wid + i) + (lane >> 5), kk = (sub >> 2) * 8 + ((lane & 31) >> 2), c = (sub & 3) * 32 + (lane & 3) * 8;
    const int k = (kk & ~0xC) | ((kk & 4) << 1) | ((kk & 8) >> 1); offV[i] = (unsigned)(k * (LDX * 2) + c * 2); }
  const unsigned dstK = lds0 + (DQK == 128 ? 2 * wid : wid) * 1024, dstV = lds0 + SLOT_V + 2 * wid * 1024;
#define ATT_DMA(t, slotoff) do { const char* kb_ = (const char*)Kh + (size_t)(t) * (KVBLK * LDX * 2); const char* vb_ = (const char*)Vh + (size_t)(t) * (KVBLK * LDX * 2); \
    glds16(kb_, offK[0], dstK + (slotoff)); if constexpr (DQK == 128) glds16(kb_, offK[1], dstK + (slotoff) + 1024); \
    glds16(vb_, offV[0], dstV + (slotoff)); glds16(vb_, offV[1], dstV + (slotoff) + 1024); } while (0)
#define ATT_NEXT(so) ((so) == 2 * SLOT ? 0 : (so) + SLOT)
  const int vb0 = (int)lds0 + SLOT_V + v_rd_base(lane);
  f32x16 pA0, pA1, pB0, pB1; bf16x8 pa0, pa1, pa2, pa3; const int NT = seq / KVBLK;
  ATT_DMA(0, 0); ATT_DMA(1, SLOT);
  if constexpr (DQK == 128) asm volatile("s_waitcnt vmcnt(4)\n\ts_barrier" ::: "memory"); else asm volatile("s_waitcnt vmcnt(3)\n\ts_barrier" ::: "memory");
  qkt<DQK>(pA0, pA1, lds, qr, r32, hi); partialSM(pA0);
  ATT_WAIT_BAR();
  int so_p = 0, so_c = SLOT, so_n = 2 * SLOT;
  for (int j = 1; j + 1 < NT; j += 2) {
    ATT_SBAR(); qkt<DQK>(pB0, pB1, lds + so_c, qr, r32, hi);
    if (j + 1 < NT) ATT_DMA(j + 1, so_n);
    finishSM(pA0, pA1, l_reg, pa0, pa1, pa2, pa3); ATT_SBAR();
    pv_d0(o, vb0 + so_p, pa0, pa1, pa2, pa3); partialSM(pB0);
    ATT_WAIT_BAR();
    so_p = so_c; so_c = ATT_NEXT(so_c); so_n = ATT_NEXT(so_n);
    ATT_SBAR(); qkt<DQK>(pA0, pA1, lds + so_c, qr, r32, hi);
    if (j + 2 < NT) ATT_DMA(j + 2, so_n);
    finishSM(pB0, pB1, l_reg, pa0, pa1, pa2, pa3); ATT_SBAR();
    pv_d0(o, vb0 + so_p, pa0, pa1, pa2, pa3); partialSM(pA0);
    ATT_WAIT_BAR();
    so_p = so_c; so_c = ATT_NEXT(so_c); so_n = ATT_NEXT(so_n);
  }
  ATT_SBAR(); qkt<DQK>(pB0, pB1, lds + so_c, qr, r32, hi);
  finishSM(pA0, pA1, l_reg, pa0, pa1, pa2, pa3); ATT_SBAR();
  pv_d0(o, vb0 + so_p, pa0, pa1, pa2, pa3); partialSM(pB0);
  finishSM(pB0, pB1, l_reg, pa0, pa1, pa2, pa3); ATT_SBAR();
  pv_d0(o, vb0 + so_c, pa0, pa1, pa2, pa3);
  { auto rr = __builtin_amdgcn_permlane32_swap(__float_as_uint(l_reg), __float_as_uint(l_reg), false, false); l_reg = __uint_as_float(rr[0]) + __uint_as_float(rr[1]); }
  if (hi == 0) li_l[r32] = l_reg; asm volatile("s_waitcnt lgkmcnt(0)" ::: "memory");
  float rli[16];
#pragma unroll
  for (int r = 0; r < 16; ++r) rli[r] = __builtin_amdgcn_rcpf(li_l[crow(r, hi)]);
  if constexpr (OUTF32) {
    bf16_t* Ow = (bf16_t*)Ob + (long)(wid * QBLK) * ldo;
    const bool odd = (r32 & 1) != 0;
#pragma unroll
    for (int r = 0; r < 16; r += 2) { const int orow = crow(r, hi) + (odd ? 1 : 0);
#pragma unroll
      for (int d0 = 0; d0 < 4; ++d0) { const float xa = o[d0][r] * rli[r], xb = o[d0][r + 1] * rli[r + 1];
        const float send = odd ? xa : xb, keep = odd ? xb : xa;
        const float recv = __int_as_float(__builtin_amdgcn_mov_dpp(__float_as_int(send), 0xB1, 0xf, 0xf, true));
        const unsigned w = pg8::cvt_pk_bf16(odd ? recv : keep, odd ? keep : recv);
        *(unsigned*)(Ow + (long)orow * ldo + d0 * 32 + (r32 & ~1)) = w; } }
  } else {
    bf16_t* Ow = (bf16_t*)Ob + (long)(wid * QBLK) * ldo;
#pragma unroll
    for (int r = 0; r < 16; ++r) { const int orow = crow(r, hi);
#pragma unroll
      for (int d0 = 0; d0 < 4; ++d0) Ow[(long)orow * ldo + d0 * 32 + r32] = (bf16_t)(cvtpk(o[d0][r] * rli[r], 0.f) & 0xffffu); }
  }
#undef ATT_DMA
#undef ATT_NEXT
}
}
constexpr int NWAVES = 8, NTHR = 512;
constexpr int DM = 4096, NB = 2, SEQ = 8192, CTX = 256, DEPTH = 2, DFF = 11008, INC = 12800;
constexpr int ROWS_B = 8448, MROWS = NB * ROWS_B, NCHUNK = MROWS / 16;
constexpr int C_AQ = 0, C_CQ = 1536, C_BQ = 2816, C_BG = 4096, C_AK = 5376, C_AV = 5888, C_CK = 6400, C_CV = 7680, C_BI = 8960, C_BFF = 10240, C_BFB = 11520;
constexpr int BW = 1280;
constexpr float EPS = 1e-6f;
#ifndef DBL
#define DBL 0
#endif
#define WGM_IN 4
#define WGM_OUT 4
#define WGM_GU 4
#define WGM_DN 4
#ifndef MK_ONE_LAUNCH
#define MK_ONE_LAUNCH 1
#endif
constexpr int N_PHASES = 2 + 9 * DEPTH;

constexpr size_t MiB = 1u << 20;
constexpr size_t al256(size_t x) { return (x + 255) / 256 * 256; }
constexpr size_t WS_CTL = 0, CTL_ZERO_BYTES = 1 * MiB;
constexpr size_t SZ_WIN = (size_t)INC * DM * 2, SZ_WOUT = (size_t)DM * DM * 2, SZ_WGU = (size_t)2 * DFF * DM * 2, SZ_WDN = (size_t)DM * DFF * 2;
constexpr size_t WS_WIN = 1 * MiB, WS_WOUT = WS_WIN + DEPTH * SZ_WIN, WS_WGU = WS_WOUT + DEPTH * SZ_WOUT, WS_WDN = WS_WGU + DEPTH * SZ_WGU;
constexpr size_t WS_MODP = WS_WDN + DEPTH * SZ_WDN;
constexpr size_t WS_MOD = WS_MODP + (size_t)16 * 2 * 3 * 24576 * 4;
constexpr size_t WS_XRES = al256(WS_MOD + (size_t)2 * 3 * 24576 * 4);
constexpr size_t WS_HX = WS_XRES + (size_t)MROWS * DM * 4;
constexpr size_t WS_QKV = WS_HX + (size_t)MROWS * DM * 2;
constexpr size_t WS_MIX = WS_QKV + (size_t)MROWS * INC * 2;
constexpr size_t WS_OC = WS_MIX + (size_t)MROWS * DM * 2;
constexpr size_t SZ_SC = (size_t)MROWS * BW * 2;
constexpr size_t WS_QT = WS_OC + (size_t)MROWS * 2560 * 4;
constexpr size_t WS_KT = WS_QT + 2 * SZ_SC, WS_KP = WS_KT + 2 * SZ_SC, WS_VT = WS_KP + 2 * SZ_SC;
constexpr size_t WS_DEC = WS_VT + SZ_SC;
constexpr size_t WS_OB = WS_DEC + (size_t)2 * NCHUNK * BW * 4;
constexpr size_t WS_PART = WS_OB + (size_t)2 * MROWS * BW * 4;
constexpr size_t WS_END = WS_PART + (size_t)8 * 512 * DM * 4;
constexpr int CW_TMO = 0, CW_BAR = 4096, CW_WQ = 8192;

constexpr int RING_BYTES = 131072, MISC_OFF = RING_BYTES + 320, LDS_BYTES = 147456;

#define GAS __attribute__((address_space(1)))
#define LAS __attribute__((address_space(3)))
typedef unsigned short bf16;
typedef unsigned v4u __attribute__((ext_vector_type(4)));
typedef unsigned v2u __attribute__((ext_vector_type(2)));
typedef float f32x4 __attribute__((ext_vector_type(4)));
typedef float f32x2 __attribute__((ext_vector_type(2)));
typedef short bf16x8 __attribute__((ext_vector_type(8)));
typedef short s16x4 __attribute__((ext_vector_type(4)));
typedef GAS unsigned gu32;
#define RLX_AGENT __ATOMIC_RELAXED, __HIP_MEMORY_SCOPE_AGENT
#define LDS_WAIT() asm volatile("s_waitcnt lgkmcnt(0)" ::: "memory")
typedef __bf16 bf16x2_t __attribute__((ext_vector_type(2)));
__device__ __forceinline__ unsigned pkbf(float lo, float hi) { f32x2 v = {lo, hi}; bf16x2_t b = __builtin_convertvector(v, bf16x2_t); return __builtin_bit_cast(unsigned, b); }
__device__ __forceinline__ float bf2f(unsigned short h) { return __uint_as_float((unsigned)h << 16); }
__device__ __forceinline__ float bflo(unsigned w) { return __uint_as_float(w << 16); }
__device__ __forceinline__ float bfhi(unsigned w) { return __uint_as_float(w & 0xffff0000u); }
template <int M> __device__ __forceinline__ float swz_xor(float v) { return __int_as_float(__builtin_amdgcn_ds_swizzle(__float_as_int(v), 0x1f | (M << 10))); }
__device__ __forceinline__ float half_sum(float v) {
    v += swz_xor<1>(v); v += swz_xor<2>(v); v += swz_xor<4>(v); v += swz_xor<8>(v); v += swz_xor<16>(v);
    return v;
}
__device__ __forceinline__ float wave_sum(float v) {
    v = half_sum(v);
    auto rr = __builtin_amdgcn_permlane32_swap(__float_as_uint(v), __float_as_uint(v), false, false);
    return __uint_as_float(rr[0]) + __uint_as_float(rr[1]);
}
__device__ __forceinline__ float bcast_lane(float v, int j) { return __int_as_float(__builtin_amdgcn_readlane(__float_as_int(v), j)); }
__device__ __forceinline__ float silu_f(float x) { return x * __builtin_amdgcn_rcpf(1.0f + __expf(-x)); }
#define XB_TMO      128
#define XB_XCNT(j)  (256  + 64 * (j))
#define XB_XSUB(j)  (1280 + 64 * (j))
#define XB_XGEN(j)  (2304 + 64 * (j))
#define XB_TOP      3328
#define XB_TOPGEN   3392
#define XCD_BAR_WORDS 3456
#define XB_SPIN_CAP (1u << 18)

__device__ __forceinline__ unsigned xb_ld(unsigned* p)              { return __hip_atomic_load(p, __ATOMIC_RELAXED, __HIP_MEMORY_SCOPE_AGENT); }
__device__ __forceinline__ unsigned xb_add(unsigned* p, unsigned v) { return __hip_atomic_fetch_add(p, v, __ATOMIC_RELAXED, __HIP_MEMORY_SCOPE_AGENT); }
__device__ __forceinline__ unsigned xb_xcc_id() { return (unsigned)__builtin_amdgcn_s_getreg((3 << 11) | 20) & 0xFu; }
#define XB_SPIN(cond, bar) do { unsigned _sp = 0; while (cond) { __builtin_amdgcn_s_sleep(1); \
    if ((++_sp & 255u) == 0u) { if (xb_ld(&(bar)[XB_TMO])) break; if (_sp > XB_SPIN_CAP) { atomicAdd(&(bar)[XB_TMO], 1u); break; } } } } while (0)

struct XcdBarrier {
    unsigned* bar; unsigned x;
    volatile LAS unsigned* st;
};

__device__ __forceinline__ XcdBarrier xcd_barrier_post(unsigned* bar, volatile LAS unsigned* st) {
    XcdBarrier b; b.bar = bar; b.x = xb_xcc_id(); b.st = st;
    if (threadIdx.x == 0) (void)xb_add(&bar[XB_XCNT(b.x)], 1u);
    return b;
}
__device__ __forceinline__ void xcd_barrier_complete(unsigned* bar, unsigned x, unsigned& nloc, unsigned& nx) {
    const unsigned G = gridDim.x * gridDim.y * gridDim.z;
    unsigned sum, cnt, mine, sp = 0u;
    for (;;) {
        sum = 0u; cnt = 0u; mine = 0u;
#pragma unroll
        for (unsigned j = 0; j < 16; ++j) { const unsigned c = xb_ld(&bar[XB_XCNT(j)]); sum += c; cnt += (c > 0u) ? 1u : 0u; mine = (j == x) ? c : mine; }
        if (sum == G) break;
        __builtin_amdgcn_s_sleep(1);
        if ((++sp & 255u) == 0u) { if (xb_ld(&bar[XB_TMO])) break; if (sp > XB_SPIN_CAP) { atomicAdd(&bar[XB_TMO], 1u); break; } }
    }
    nloc = mine > 0u ? mine : 1u; nx = cnt > 0u ? cnt : 1u;
}

__device__ __forceinline__ void xcd_barrier(const XcdBarrier& b) {
    asm volatile("s_waitcnt vmcnt(0)" ::: "memory");
    __syncthreads();
    if (threadIdx.x == 0) {
        unsigned* bar = b.bar;
        __builtin_amdgcn_s_waitcnt(0);
        unsigned nloc = b.st[0], nx = b.st[1];
        if (nloc == 0u) { xcd_barrier_complete(bar, b.x, nloc, nx); b.st[0] = nloc; b.st[1] = nx; }
        const unsigned old = xb_add(&bar[XB_XSUB(b.x)], 1u);
        const unsigned gen = old / nloc;
        if (old + 1u == (gen + 1u) * nloc) {
            __builtin_amdgcn_fence(__ATOMIC_RELEASE, "agent");
            asm volatile("s_waitcnt vmcnt(0)" ::: "memory");
            const unsigned og = xb_add(&bar[XB_TOP], 1u);
            const unsigned tg = og / nx;
            if (og + 1u == (tg + 1u) * nx) xb_add(&bar[XB_TOPGEN], 1u);
            else XB_SPIN(xb_ld(&bar[XB_TOPGEN]) == tg, bar);
            __builtin_amdgcn_fence(__ATOMIC_ACQUIRE, "agent");
            xb_add(&bar[XB_XGEN(b.x)], 1u);
            asm volatile("s_waitcnt vmcnt(0)" ::: "memory");
        } else {
            XB_SPIN(xb_ld(&bar[XB_XGEN(b.x)]) == gen, bar);
            __builtin_amdgcn_fence(__ATOMIC_ACQUIRE, "agent");
            asm volatile("s_waitcnt vmcnt(0)" ::: "memory");
        }
    }
    __syncthreads();
}
struct Args { const float* in[19]; float* out; unsigned char* ws; int ph_lo, ph_hi; };
typedef const Args __attribute__((address_space(4)))* KArgs;
__device__ __forceinline__ KArgs fresh_args() { KArgs p = (KArgs)__builtin_amdgcn_kernarg_segment_ptr(); asm volatile("" : "+s"(p)); return p; }
constexpr int I_IN = 64 * 400, I_OUT = 64 * 128, I_G = 64 * 344, I_DN = 172 * 128, I_LAYER = I_IN + I_OUT + 2 * I_G + I_DN;
constexpr int CONV_PER_WAVE = 12, CONV_UNIT = 8 * CONV_PER_WAVE, N_CONV_UNITS = (DEPTH * I_LAYER - I_IN + CONV_UNIT - 1) / CONV_UNIT;
struct ConvItem { const float* src; bf16* dst; int N, pitch; };
__device__ __forceinline__ ConvItem conv_decode(KArgs P, int it, int lane) {
    const int l = it / I_LAYER; int r = it % I_LAYER; const float* W; bf16* WT; int N, pitch, k0, n0, drow;
    if (r < I_IN) { const int kb = r / 400, nb = r % 400; W = P->in[6] + (size_t)l * DM * INC; N = INC; WT = (bf16*)(P->ws + WS_WIN + l * SZ_WIN); pitch = DM; k0 = 64 * kb; n0 = 32 * nb; drow = n0; }
    else if ((r -= I_IN) < I_OUT) { const int kb = r / 128, nb = r % 128; W = P->in[7] + (size_t)l * DM * DM; N = DM; WT = (bf16*)(P->ws + WS_WOUT + l * SZ_WOUT); pitch = DM; k0 = 64 * kb; n0 = 32 * nb; drow = n0; }
    else if ((r -= I_OUT) < 2 * I_G) { const int up = r >= I_G; if (up) r -= I_G; const int kb = r / 344, nb = r % 344; n0 = 32 * nb;
        W = (up ? P->in[17] : P->in[16]) + (size_t)l * DM * DFF; N = DFF; WT = (bf16*)(P->ws + WS_WGU + l * SZ_WGU); pitch = DM; k0 = 64 * kb; drow = (n0 >> 7) * 256 + (n0 & 127) + (up ? 128 : 0); }
    else { r -= 2 * I_G; const int kb = r / 128, nb = r % 128; W = P->in[18] + (size_t)l * DFF * DM; N = DM; WT = (bf16*)(P->ws + WS_WDN + l * SZ_WDN); pitch = DFF; k0 = 64 * kb; n0 = 32 * nb; drow = n0; }
    ConvItem c; c.src = W + (size_t)(k0 + (lane >> 5)) * N + n0 + (lane & 31); c.dst = WT + (size_t)drow * pitch + k0; c.N = N; c.pitch = pitch; return c;
}
__device__ __forceinline__ void conv_load(float (&v)[32], const ConvItem& c) {
#pragma unroll
    for (int i = 0; i < 32; ++i) v[i] = __builtin_nontemporal_load(c.src + (size_t)(2 * i) * c.N);
}
__device__ __forceinline__ void conv_finish(const float (&v)[32], const ConvItem& c, LAS float* scr, int lane) {
#pragma unroll
    for (int i = 0; i < 32; ++i) scr[(2 * i + (lane >> 5)) * 33 + (lane & 31)] = v[i];
    LDS_WAIT(); asm volatile("" ::: "memory");
    const int cc = lane & 7;
#pragma unroll
    for (int j = 0; j < 4; ++j) { const int n = (lane >> 3) + 8 * j; const LAS float* s = scr + (8 * cc) * 33 + n;
        v4u o; o.x = pkbf(s[0 * 33], s[1 * 33]); o.y = pkbf(s[2 * 33], s[3 * 33]); o.z = pkbf(s[4 * 33], s[5 * 33]); o.w = pkbf(s[6 * 33], s[7 * 33]);
        __builtin_nontemporal_store(o, (GAS v4u*)(c.dst + (size_t)n * c.pitch + 8 * cc)); }
    LDS_WAIT(); asm volatile("" ::: "memory");
}
template <int NI> __device__ __forceinline__ void conv_run(KArgs P, int it0, int stride, int last, LAS float* scr, int lane) {
    float va[32], vb[32];
#define CONV_IT(k) (it0 + (k) * stride < last ? it0 + (k) * stride : last)
    ConvItem ca = conv_decode(P, CONV_IT(0), lane), cb = ca; conv_load(va, ca);
#pragma unroll 1
    for (int k = 0; k + 2 < NI; k += 2) {
        cb = conv_decode(P, CONV_IT(k + 1), lane); conv_load(vb, cb);
        conv_finish(va, ca, scr, lane);
        ca = conv_decode(P, CONV_IT(k + 2), lane); conv_load(va, ca);
        conv_finish(vb, cb, scr, lane);
    }
    if constexpr (NI % 2 == 0) { cb = conv_decode(P, CONV_IT(NI - 1), lane); conv_load(vb, cb); conv_finish(va, ca, scr, lane); conv_finish(vb, cb, scr, lane); }
    else conv_finish(va, ca, scr, lane);
#undef CONV_IT
}
__device__ __forceinline__ void p0_prologue(KArgs P, LAS unsigned char* lds, int gw, int NGW, int wave, int lane) {
    LAS float* scr = (LAS float*)(lds + wave * 16384);
    conv_run<13>(P, gw, NGW, I_IN - 1, scr, lane);
    for (int it = gw + 13 * NGW; it < I_IN; it += NGW) conv_run<1>(P, it, NGW, I_IN - 1, scr, lane);
    float* modp = (float*)(P->ws + WS_MODP);
    for (int it = gw; it < 2 * 96 * 16; it += NGW) {
        const int kp = it & 15, cb = (it >> 4) % 96, l = it / (16 * 96);
        f32x4 a0 = {0.f, 0.f, 0.f, 0.f}, a1 = a0, a2 = a0;
        const float* wb = P->in[4] + ((size_t)l * DM + 256 * kp) * 24576 + 256 * cb + 4 * lane;
        for (int kb = 0; kb < 4; ++kb) {
            const int k0 = 256 * kp + 64 * kb;
            const float s0 = silu_f(P->in[1][k0 + lane]), s1 = silu_f(P->in[1][DM + k0 + lane]), s2 = silu_f(P->in[3][k0 + lane]);
#pragma unroll 8
            for (int j = 0; j < 64; ++j) {
                const f32x4 w = *(const f32x4*)(wb + (size_t)(64 * kb + j) * 24576);
                a0 += w * bcast_lane(s0, j); a1 += w * bcast_lane(s1, j); a2 += w * bcast_lane(s2, j);
            }
        }
        float* o = modp + ((size_t)(kp * 2 + l) * 3) * 24576 + 256 * cb + 4 * lane;
        *(f32x4*)(o) = a0; *(f32x4*)(o + 24576) = a1; *(f32x4*)(o + 2 * 24576) = a2;
    }
}
__device__ __forceinline__ void p1_modreduce(KArgs P, int gtid, int NGT) {
    const float* modp = (const float*)(P->ws + WS_MODP); float* mod = (float*)(P->ws + WS_MOD);
    for (int i = gtid; i < 2 * 3 * 24576; i += NGT) {
        const int n = i % 24576, l = i / (3 * 24576);
        float s = P->in[5][l * 24576 + n];
#pragma unroll
        for (int kp = 0; kp < 16; ++kp) s += modp[(size_t)kp * (2 * 3 * 24576) + i];
        mod[i] = s;
    }
}
__device__ __forceinline__ void norm_phase(KArgs P, int l, int shift_idx, int scale_idx, int from_in, int skip_ctx, int add_parts, int gw, int ngw, int lane) {
    const bf16* xres = (const bf16*)(P->ws + WS_XRES); bf16* hx = (bf16*)(P->ws + WS_HX);
    const float* modl = (const float*)(P->ws + WS_MOD) + (size_t)l * 3 * 24576;
    for (int row = gw; row < MROWS; row += ngw) {
        const int b = row / ROWS_B, j = row % ROWS_B, rsel = (j < CTX) ? 2 : b;
        if (skip_ctx && j < CTX) continue;
        const f32x4* sh = (const f32x4*)(modl + rsel * 24576 + shift_idx * DM) + lane;
        const f32x4* sc = (const f32x4*)(modl + rsel * 24576 + scale_idx * DM) + lane;
        f32x4 v[16], sa1[8], sa0[8]; float ss = 0.f;
        if (from_in) { const float* src = (j < CTX) ? P->in[2] + ((size_t)b * CTX + j) * DM : P->in[0] + ((size_t)b * SEQ + (j - CTX)) * DM;
            const f32x4* xr = (const f32x4*)src + lane;
#pragma unroll
            for (int q = 0; q < 16; ++q) v[q] = xr[64 * q];
#pragma unroll
            for (int q = 0; q < 8; ++q) { sa1[q] = sc[64 * q]; sa0[q] = sh[64 * q]; } }
        else { const v2u* xb = (const v2u*)(xres + (size_t)row * DM) + lane; v2u t[16];
#pragma unroll
            for (int q = 0; q < 16; ++q) t[q] = xb[64 * q];
#pragma unroll
            for (int q = 0; q < 8; ++q) { sa1[q] = sc[64 * q]; sa0[q] = sh[64 * q]; }
#pragma unroll
            for (int q = 0; q < 16; ++q) v[q] = (f32x4){__uint_as_float(t[q].x << 16), __uint_as_float(t[q].x & 0xffff0000u), __uint_as_float(t[q].y << 16), __uint_as_float(t[q].y & 0xffff0000u)}; }
#pragma unroll
        for (int q = 0; q < 16; ++q) ss += (v[q].x * v[q].x + v[q].y * v[q].y) + (v[q].z * v[q].z + v[q].w * v[q].w);
        if (add_parts && j < CTX) {
            const f32x4* pp = (const f32x4*)(P->ws + WS_PART + ((size_t)(b * 256 + j) * DM) * 4) + lane; ss = 0.f;
#pragma unroll
            for (int q = 0; q < 16; ++q) { f32x4 t[8];
#pragma unroll
                for (int sl = 0; sl < 8; ++sl) t[sl] = pp[(size_t)sl * 512 * DM / 4 + 64 * q];
                f32x4 a = v[q];
#pragma unroll
                for (int sl = 0; sl < 8; ++sl) a += t[sl];
                v[q] = a; ss += (a.x * a.x + a.y * a.y) + (a.z * a.z + a.w * a.w); } }
        f32x4 sb1[8], sb0[8];
#pragma unroll
        for (int q = 0; q < 8; ++q) { sb1[q] = sc[64 * (q + 8)]; sb0[q] = sh[64 * (q + 8)]; }
        if ((from_in || add_parts) && j < CTX) { v2u* xo = (v2u*)(P->ws + WS_XRES + (size_t)row * DM * 2) + lane;
#pragma unroll
            for (int q = 0; q < 16; ++q) { v2u w; w.x = pkbf(v[q].x, v[q].y); w.y = pkbf(v[q].z, v[q].w); xo[64 * q] = w; } }
        const float rstd = __builtin_amdgcn_rsqf(wave_sum(ss) * (1.f / DM) + EPS);
        v2u* o = (v2u*)(hx + (size_t)row * DM) + lane;
#pragma unroll
        for (int q = 0; q < 8; ++q) { const f32x4 y = v[q] * rstd * (sa1[q] + 1.0f) + sa0[q];
            v2u w; w.x = pkbf(y.x, y.y); w.y = pkbf(y.z, y.w); o[64 * q] = w; }
#pragma unroll
        for (int q = 0; q < 8; ++q) { const f32x4 y = v[q + 8] * rstd * (sb1[q] + 1.0f) + sb0[q];
            v2u w; w.x = pkbf(y.x, y.y); w.y = pkbf(y.z, y.w); o[64 * (q + 8)] = w; }
    }
}
__device__ __forceinline__ void scanprep_phase(KArgs P, int l, int gtid, int NGT) {
    const bf16* qkv = (const bf16*)(P->ws + WS_QKV);
    bf16* QT = (bf16*)(P->ws + WS_QT); bf16* KT = (bf16*)(P->ws + WS_KT); bf16* KP = (bf16*)(P->ws + WS_KP); bf16* VT = (bf16*)(P->ws + WS_VT);
    float* DEC = (float*)(P->ws + WS_DEC);
    for (int idx = gtid; idx < NCHUNK * BW; idx += NGT) {
        const int ch = idx / BW, hd = idx % BW;
        float lbf = 0.f, lbb = 0.f;
        if (l > 0) { lbf = 1.f / (1.f + __expf(P->in[10][0 * 2 * BW + 0 * BW + hd] - P->in[10][1 * 2 * BW + 0 * BW + hd]));
                     lbb = 1.f / (1.f + __expf(P->in[10][0 * 2 * BW + 1 * BW + hd] - P->in[10][1 * 2 * BW + 1 * BW + hd])); }
        const bf16* base = qkv + (size_t)(ch * 16) * INC + hd;
        float q[16], gf[16], of[16], gb[16], ob[16]; unsigned short vv[16], rq[16], rzf[16], rzb[16];
#pragma unroll
        for (int t = 0; t < 16; ++t) { const bf16* rp = base + (size_t)t * INC; rq[t] = rp[C_BQ]; vv[t] = rp[C_BI]; rzf[t] = rp[C_BFF]; rzb[t] = rp[C_BFB]; }
        __builtin_amdgcn_sched_barrier(0);
#pragma unroll
        for (int t = 0; t < 16; ++t) {
            q[t] = silu_f(bf2f(rq[t]));
            const float zf = bf2f(rzf[t]), zb = bf2f(rzb[t]);
            const float ef = __expf(-zf), sf = __builtin_amdgcn_rcpf(1.f + ef); gf[t] = __logf(lbf + (1.f - lbf) * sf); of[t] = (1.f - lbf) * ef * sf;
            const float eb = __expf(-zb), sb = __builtin_amdgcn_rcpf(1.f + eb); gb[t] = __logf(lbb + (1.f - lbb) * sb); ob[t] = (1.f - lbb) * eb * sb;
        }
        const int dl = hd & 31, pos = (hd & ~31) + 8 * ((dl >> 2) & 3) + 4 * (dl >> 4) + (dl & 3);
        { float b = 0.f; float bt[16];
#pragma unroll
          for (int t = 0; t < 16; ++t) { b += gf[t]; bt[t] = b; }
          unsigned kp[8];
#pragma unroll
          for (int t = 0; t < 16; ++t) { const float e = __expf(bt[t]);
              QT[(size_t)(ch * 16 + t) * BW + pos] = (bf16)(pkbf(q[t] * e, 0.f) & 0xffffu);
              KT[(size_t)(ch * 16 + t) * BW + pos] = (bf16)(pkbf(of[t] * __expf(-bt[t]), 0.f) & 0xffffu); }
#pragma unroll
          for (int t = 0; t < 16; t += 2) kp[t >> 1] = pkbf(of[t] * __expf(b - bt[t]), of[t + 1] * __expf(b - bt[t + 1]));
          v4u* o = (v4u*)(KP + ((size_t)ch * BW + hd) * 16); o[0] = (v4u){kp[0], kp[1], kp[2], kp[3]}; o[1] = (v4u){kp[4], kp[5], kp[6], kp[7]};
          DEC[(size_t)ch * BW + hd] = __expf(b); }
        { float b = 0.f; float bt[16];
#pragma unroll
          for (int t = 15; t >= 0; --t) { b += gb[t]; bt[t] = b; }
          unsigned kp[8];
          bf16* QTb = QT + (size_t)MROWS * BW; bf16* KTb = KT + (size_t)MROWS * BW;
#pragma unroll
          for (int t = 0; t < 16; ++t) { const float e = __expf(bt[t]);
              QTb[(size_t)(ch * 16 + t) * BW + pos] = (bf16)(pkbf(q[t] * e, 0.f) & 0xffffu);
              KTb[(size_t)(ch * 16 + t) * BW + pos] = (bf16)(pkbf(ob[t] * __expf(-bt[t]), 0.f) & 0xffffu); }
#pragma unroll
          for (int t = 0; t < 16; t += 2) kp[t >> 1] = pkbf(ob[t] * __expf(b - bt[t]), ob[t + 1] * __expf(b - bt[t + 1]));
          v4u* o = (v4u*)(KP + (size_t)MROWS * BW + ((size_t)ch * BW + hd) * 16); o[0] = (v4u){kp[0], kp[1], kp[2], kp[3]}; o[1] = (v4u){kp[4], kp[5], kp[6], kp[7]};
          DEC[(size_t)NCHUNK * BW + (size_t)ch * BW + hd] = __expf(b); }
        { v4u* o = (v4u*)(VT + ((size_t)ch * BW + hd) * 16);
          o[0] = (v4u){vv[0] | ((unsigned)vv[1] << 16), vv[2] | ((unsigned)vv[3] << 16), vv[4] | ((unsigned)vv[5] << 16), vv[6] | ((unsigned)vv[7] << 16)};
          o[1] = (v4u){vv[8] | ((unsigned)vv[9] << 16), vv[10] | ((unsigned)vv[11] << 16), vv[12] | ((unsigned)vv[13] << 16), vv[14] | ((unsigned)vv[15] << 16)}; }
    }
}
constexpr int SC_SLOT = 17408, SC_NSLOT = 4;
__device__ __forceinline__ void sc_glds16(const void* sbase, unsigned voff, unsigned lds_dst) { unsigned keep;
  asm volatile("s_mov_b32 %0, m0\n\ts_mov_b32 m0, %3\n\ts_nop 0\n\tglobal_load_lds_dwordx4 %1, %2\n\ts_mov_b32 m0, %0" : "=&s"(keep) : "v"(voff), "s"(sbase), "s"(lds_dst) : "memory"); }
__device__ __forceinline__ void sc_glds4(const void* sbase, unsigned voff, unsigned lds_dst) { unsigned keep;
  asm volatile("s_mov_b32 %0, m0\n\ts_mov_b32 m0, %3\n\ts_nop 0\n\tglobal_load_lds_dword %1, %2\n\ts_mov_b32 m0, %0" : "=&s"(keep) : "v"(voff), "s"(sbase), "s"(lds_dst) : "memory"); }
__device__ __forceinline__ void scan_unit(KArgs P, int chain, int wave, LAS unsigned char* ldsl) {
    const int lane = opaque_lane();
    const int b = chain / 20, h = (chain >> 1) % 10, dir = chain & 1;
    bf16* OB = (bf16*)(P->ws + WS_OB) + (size_t)dir * MROWS * BW;
    const int l16 = lane & 15, g = lane >> 4;
    const unsigned lds0 = (unsigned)(uintptr_t)ldsl;
    const int kind = wave >> 1, half = wave & 1;
    const char* src = (const char*)(P->ws + (kind == 0 ? WS_QT : kind == 1 ? WS_KT : kind == 2 ? WS_KP : WS_VT)) + (kind == 3 ? (size_t)0 : (size_t)dir * SZ_SC) + (kind < 2 ? h * 256 : h * 4096);
    unsigned voff[2];
#pragma unroll
    for (int i = 0; i < 2; ++i) { const int pr = 2 * half + i;
        if (kind < 2) { const int row = 4 * pr + (lane >> 4), logical = (lane & 15) ^ row; voff[i] = (unsigned)(row * (BW * 2) + logical * 16); }
        else voff[i] = (unsigned)(pr * 1024 + lane * 16); }
    const unsigned dst = lds0 + kind * 4096 + 2 * half * 1024, dstdec = lds0 + 16384 + half * 256;
    const char* srcdec = (const char*)(P->ws + WS_DEC) + ((size_t)dir * NCHUNK * BW + h * 128) * 4 + half * 256;
#define SC_CHUNK(ci) (b * 528 + (dir ? ((ci) < 16 ? 15 - (ci) : 543 - (ci)) : (ci)))
#define SC_DMA(ci, so) do { const int ch_ = SC_CHUNK(ci); const char* s_ = src + (size_t)ch_ * 40960; \
        sc_glds16(s_, voff[0], dst + (so)); sc_glds16(s_, voff[1], dst + (so) + 1024); sc_glds4(srcdec + (size_t)ch_ * 5120, (unsigned)lane * 4u, dstdec + (so)); } while (0)
#define SC_NEXT(so) ((so) == (SC_NSLOT - 1) * SC_SLOT ? 0 : (so) + SC_SLOT)
    const int a_qk = l16 * 256, a_kp = 8192 + l16 * 32 + 8 * g, a_vt = 12288 + (16 * wave + l16) * 32 + 8 * g, a_dec = 16384 + 16 * g;
    f32x4 S[8];
#pragma unroll
    for (int j = 0; j < 8; ++j) S[j] = (f32x4){0.f, 0.f, 0.f, 0.f};
    bool keep[4];
#pragma unroll
    for (int i = 0; i < 4; ++i) keep[i] = dir ? (4 * g + i >= l16) : (4 * g + i <= l16);
    SC_DMA(0, 0); SC_DMA(1, SC_SLOT); SC_DMA(2, 2 * SC_SLOT);
    int so = 0, so_n = 3 * SC_SLOT;
    for (int ci = 0; ci < 528; ++ci) {
        if (ci >= 3 && ci + 3 < 528) asm volatile("s_waitcnt vmcnt(18) lgkmcnt(0)\n\ts_barrier" ::: "memory");
        else asm volatile("s_waitcnt vmcnt(0) lgkmcnt(0)\n\ts_barrier" ::: "memory");
        if (ci + 3 < 528) SC_DMA(ci + 3, so_n);
        const LAS unsigned char* sb = ldsl + so;
        bf16x8 qf[4], kf[4]; s16x4 kp[8]; f32x4 dec[8];
#pragma unroll
        for (int j2 = 0; j2 < 4; ++j2) { const int co = ((4 * j2 + g) ^ l16) * 16; qf[j2] = *(const LAS bf16x8*)(sb + a_qk + co); kf[j2] = *(const LAS bf16x8*)(sb + 4096 + a_qk + co); }
#pragma unroll
        for (int j = 0; j < 8; ++j) { kp[j] = *(const LAS s16x4*)(sb + a_kp + 512 * j); dec[j] = *(const LAS f32x4*)(sb + a_dec + 64 * j); }
        const s16x4 vt = *(const LAS s16x4*)(sb + a_vt);
        const int ch = SC_CHUNK(ci);
        f32x4 pt = {0.f, 0.f, 0.f, 0.f};
#pragma unroll
        for (int j2 = 0; j2 < 4; ++j2) pt = __builtin_amdgcn_mfma_f32_16x16x32_bf16(kf[j2], qf[j2], pt, 0, 0, 0);
        v2u paw; paw.x = pkbf(keep[0] ? pt[0] : 0.f, keep[1] ? pt[1] : 0.f); paw.y = pkbf(keep[2] ? pt[2] : 0.f, keep[3] ? pt[3] : 0.f);
        const s16x4 pa = __builtin_bit_cast(s16x4, paw);
        const bf16x8 pa8 = {pa[0], pa[1], pa[2], pa[3], 0, 0, 0, 0}, vt8 = {vt[0], vt[1], vt[2], vt[3], 0, 0, 0, 0};
        f32x4 o = __builtin_amdgcn_mfma_f32_16x16x32_bf16(pa8, vt8, (f32x4){0.f, 0.f, 0.f, 0.f}, 0, 0, 0);
#pragma unroll
        for (int j2 = 0; j2 < 4; ++j2) {
            v4u sw; sw.x = pkbf(S[2 * j2][0], S[2 * j2][1]); sw.y = pkbf(S[2 * j2][2], S[2 * j2][3]); sw.z = pkbf(S[2 * j2 + 1][0], S[2 * j2 + 1][1]); sw.w = pkbf(S[2 * j2 + 1][2], S[2 * j2 + 1][3]);
            o = __builtin_amdgcn_mfma_f32_16x16x32_bf16(qf[j2], __builtin_bit_cast(bf16x8, sw), o, 0, 0, 0);
        }
#pragma unroll
        for (int j = 0; j < 8; ++j) { const bf16x8 kp8 = {kp[j][0], kp[j][1], kp[j][2], kp[j][3], 0, 0, 0, 0}; S[j] = __builtin_amdgcn_mfma_f32_16x16x32_bf16(kp8, vt8, S[j] * dec[j], 0, 0, 0); }
        bf16* op = OB + (size_t)(ch * 16 + 4 * g) * BW + h * 128 + 16 * wave + l16;
#pragma unroll
        for (int i = 0; i < 4; ++i) op[(size_t)i * BW] = (bf16)(pkbf(o[i], 0.f) & 0xffffu);
        so = SC_NEXT(so); so_n = SC_NEXT(so_n);
    }
#undef SC_CHUNK
#undef SC_DMA
#undef SC_NEXT
}
__device__ __forceinline__ void mixer_phase(KArgs P, int l, unsigned char* lds_generic, LAS unsigned char* ldsl, volatile LAS unsigned* MISC, gu32* ctl, int tid, int wave, int lane) {
    static_assert(DEPTH == 2, "conversion unit split");
    const int conv_first = l == 0 ? I_IN : I_LAYER + I_IN, conv_end = l == 0 ? I_LAYER + I_IN : DEPTH * I_LAYER;
    const int n_main = 40 + 768 + 1280, n_att = n_main + (l == 0 ? 64 : 0), total = n_att + (conv_end - conv_first + CONV_UNIT - 1) / CONV_UNIT;
    const bf16* qkv = (const bf16*)(P->ws + WS_QKV); bf16* mix = (bf16*)(P->ws + WS_MIX); bf16* oc = (bf16*)(P->ws + WS_OC);
    for (;;) {
        __syncthreads();
        if (wave == 0 && opaque_lane() == 0) MISC[4] = __hip_atomic_fetch_add((unsigned*)(ctl + CW_WQ + 64 * l), 1u, __ATOMIC_RELAXED, __HIP_MEMORY_SCOPE_AGENT);
        __syncthreads();
        const int u = __builtin_amdgcn_readfirstlane((int)MISC[4]);
        if (u >= total) break;
        if (u >= n_att) {
            LAS float* scr = (LAS float*)(ldsl + wave * 16384); const int ln = opaque_lane();
            conv_run<CONV_PER_WAVE>(P, conv_first + (u - n_att) * CONV_UNIT + wave, 8, conv_end - 1, scr, ln);
            continue; }
#ifndef ATT_SD
#define ATT_SD 1
#endif
#ifndef MIX_MASK
#define MIX_MASK 7
#endif
        if (u < 40) { if (MIX_MASK & 1) scan_unit(P, u, wave, ldsl); if (DBL & 1024) { __syncthreads(); scan_unit(P, u, wave, ldsl); __syncthreads(); scan_unit(P, u, wave, ldsl); } continue; }
        const bool isA = (u < 808) || (u >= n_main && u < n_main + 24);
        if (isA) {
            int hq, b, qrow; int seq;
            if (u < 808) { const int v = u - 40, g = v % 3, qb = (v / 3) & 31, kvh = (v / 96) & 3; b = v / 384; hq = kvh * 3 + g; qrow = CTX + 256 * qb; seq = ROWS_B; }
            else { const int v = u - n_main; hq = v % 12; b = v / 12; qrow = 0; seq = CTX; }
            const int kvh = hq / 3; const size_t rq = (size_t)b * ROWS_B + qrow, rk = (size_t)b * ROWS_B;
            if (MIX_MASK & 2) att::attn_body<128, false>(qkv + rq * INC + C_AQ + 128 * hq, qkv + rk * INC + C_AK + 128 * kvh, qkv + rk * INC + C_AV + 128 * kvh, mix + rq * DM + 128 * hq, DM, seq, (char*)lds_generic, wave);
        } else {
            int m, h, b, qrow; int seq;
            if (u < n_main) { const int v = u - 808; m = v & 1; const int qb = (v >> 1) & 31; h = (v >> 6) % 10; b = v / 640; qrow = CTX + 256 * qb; seq = ROWS_B; }
            else { const int v = u - n_main - 24; m = v & 1; h = (v >> 1) % 10; b = v / 20; qrow = 0; seq = CTX; }
            const size_t rq = (size_t)b * ROWS_B + qrow, rk = (size_t)b * ROWS_B;
            if (MIX_MASK & 4) att::attn_body<64, true>(qkv + rq * INC + C_CQ + 128 * h + 64 * m, qkv + rk * INC + C_CK + 128 * h + 64 * m, qkv + rk * INC + C_CV + 128 * h, oc + rq * 2560 + 128 * (2 * h + m), 2560, seq, (char*)lds_generic, wave);
        }
    }
}
__device__ __forceinline__ void finalize_phase(KArgs P, int l, int gw, int NGW, int lane) {
    const float lam_init = (l == 0) ? 0.2f : 0.35550906759f;
    const float* dl = P->in[14] + l * 256;
    const float lam = __expf(wave_sum(dl[lane] * dl[64 + lane])) - __expf(wave_sum(dl[128 + lane] * dl[192 + lane])) + lam_init;
    const f32x2 gdo = *(const f32x2*)(P->in[15] + l * 128 + 2 * lane), gho = *(const f32x2*)(P->in[11] + l * 128 + 2 * lane);
    const bf16* oc = (const bf16*)(P->ws + WS_OC); const bf16* obf = (const bf16*)(P->ws + WS_OB); const bf16* obb = obf + (size_t)MROWS * BW;
    const bf16* qkv = (const bf16*)(P->ws + WS_QKV); bf16* mix = (bf16*)(P->ws + WS_MIX);
    for (int row = gw; row < MROWS; row += NGW) {
        if (l == DEPTH - 1 && (row % ROWS_B) < CTX) continue;
        unsigned* mrow = (unsigned*)(mix + (size_t)row * DM);
        f32x2 c0[10], c1[10], bf_[10], bb_[10]; unsigned gt[10];
#pragma unroll
        for (int h = 0; h < 10; ++h) { const unsigned t0 = *(const unsigned*)(oc + (size_t)row * 2560 + 256 * h + 2 * lane), t1 = *(const unsigned*)(oc + (size_t)row * 2560 + 256 * h + 128 + 2 * lane);
            c0[h] = (f32x2){__uint_as_float(t0 << 16), __uint_as_float(t0 & 0xffff0000u)}; c1[h] = (f32x2){__uint_as_float(t1 << 16), __uint_as_float(t1 & 0xffff0000u)}; }
#pragma unroll
        for (int h = 0; h < 10; ++h) { const unsigned tf = *(const unsigned*)(obf + (size_t)row * BW + 128 * h + 2 * lane), tb = *(const unsigned*)(obb + (size_t)row * BW + 128 * h + 2 * lane);
            bf_[h] = (f32x2){__uint_as_float(tf << 16), __uint_as_float(tf & 0xffff0000u)}; bb_[h] = (f32x2){__uint_as_float(tb << 16), __uint_as_float(tb & 0xffff0000u)};
            gt[h] = *(const unsigned*)(qkv + (size_t)row * INC + C_BG + 128 * h + 2 * lane); }
#pragma unroll
        for (int h = 0; h < 10; ++h) {
            const f32x2 d = c0[h] - c1[h] * lam;
            const float r = __builtin_amdgcn_rsqf(wave_sum(d.x * d.x + d.y * d.y) * (1.f / 128.f) + EPS) * (1.0f - lam_init);
            mrow[(2816 + 128 * h) / 2 + lane] = pkbf(d.x * r * gdo.x, d.y * r * gdo.y);
        }
#pragma unroll
        for (int h = 0; h < 10; ++h) {
            const f32x2 a = bf_[h] + bb_[h];
            const float r = __builtin_amdgcn_rsqf(wave_sum(a.x * a.x + a.y * a.y) * (1.f / 128.f) + EPS);
            mrow[(1536 + 128 * h) / 2 + lane] = pkbf(a.x * r * gho.x * silu_f(bflo(gt[h])), a.y * r * gho.y * silu_f(bfhi(gt[h])));
        }
    }
}
__global__ void __launch_bounds__(NTHR, 2) hybrid_fwd(Args args) {
    extern __shared__ __attribute__((aligned(16))) unsigned char lds[];
    LAS unsigned char* ldsl = (LAS unsigned char*)lds;
    volatile LAS unsigned* MISC = (volatile LAS unsigned*)(ldsl + MISC_OFF);
    const int G = gridDim.x, bx = blockIdx.x;
    const int wave_s = __builtin_amdgcn_readfirstlane((int)(threadIdx.x >> 6));
#define PH_IDS const int lane = opaque_lane(), wave = opaque_s(wave_s), tid = wave * 64 + lane; (void)tid; (void)lane; (void)wave; const int lq = opaque_s(l); (void)lq;
#define GW (bx * NWAVES + wave)
#define NGW (G * NWAVES)
#define GTID (bx * NTHR + tid)
#define NGT (G * NTHR)
    for (int u = threadIdx.x; u < (LDS_BYTES - RING_BYTES) / 4; u += NTHR) ((LAS unsigned*)(ldsl + RING_BYTES))[u] = 0u;
    __syncthreads();
    const int lo = args.ph_lo, hi = args.ph_hi;
    XcdBarrier bar; bar.bar = (unsigned*)(args.ws + WS_CTL) + CW_BAR; bar.x = 0; bar.st = nullptr;
    if (hi - lo > 1) bar = xcd_barrier_post((unsigned*)(args.ws + WS_CTL) + CW_BAR, MISC + 8);
#ifndef PH_MASK
#define PH_MASK 0xFFFFFFFFu
#endif
#define IN(k) (lo <= (k) && (k) < hi)
#define EN(k) ((PH_MASK >> (k)) & 1u)
#define SEAM(k) do { if (IN(k) && IN((k) + 1)) xcd_barrier(bar); } while (0)

    if (EN(0) && IN(0)) { const int l = 0; PH_IDS p0_prologue(fresh_args(), ldsl, GW, NGW, wave, lane); if (DBL & 17) { __syncthreads(); p0_prologue(fresh_args(), ldsl, GW, NGW, wave, lane); } } SEAM(0);
    if (EN(1) && IN(1)) { const int l = 0; PH_IDS p1_modreduce(fresh_args(), GTID, NGT); } SEAM(1);

#pragma unroll
    for (int l = 0; l < DEPTH; ++l) {
        const int pb = 2 + 9 * l;
        if (EN(2) && IN(pb + 0)) { PH_IDS norm_phase(fresh_args(), lq, 0, 1, lq == 0, 0, lq > 0, GW, NGW, lane); if (DBL & 33) norm_phase(fresh_args(), lq, 0, 1, lq == 0, 0, lq > 0, GW, NGW, lane); } SEAM(pb + 0);
        if (EN(3) && IN(pb + 1)) {
            const int lq = opaque_s(l); KArgs P = fresh_args(); unsigned char* ws = P->ws;
            pg8::Gemm g{(const pg8::bf16_t*)(ws + WS_HX), (const pg8::bf16_t*)(ws + WS_WIN + lq * SZ_WIN), MROWS, INC, DM}; pg8::PanelOrder S; S.init(INC, G, bx, lq == DEPTH - 1, lq == DEPTH - 1 ? 58 : 0, 0, 0, WGM_IN);
            pg8::EpiInproj E{(pg8::bf16_t*)(ws + WS_QKV), INC, P->in[8] + lq * 128, P->in[9] + lq * 128, P->in[12] + lq * 64, P->in[13] + lq * 64, (LAS float*)(ldsl + RING_BYTES + 2048)};
            pg8::gemm_phase<pg8::EpiInproj, pg8::PanelOrder, true, true>(ldsl, g, S, E, opaque_s(wave_s));
            if (DBL & 2) { __syncthreads(); pg8::gemm_phase<pg8::EpiInproj, pg8::PanelOrder, true, true>(ldsl, g, S, E, opaque_s(wave_s)); }
        } SEAM(pb + 1);
        if (EN(4) && IN(pb + 2)) { PH_IDS scanprep_phase(fresh_args(), lq, GTID, NGT); if (DBL & 65) scanprep_phase(fresh_args(), lq, GTID, NGT); } SEAM(pb + 2);
        if (EN(5) && IN(pb + 3)) { PH_IDS KArgs P = fresh_args(); mixer_phase(P, lq, lds, ldsl, MISC, (gu32*)(P->ws + WS_CTL), tid, wave, lane); if (DBL & 4) { __syncthreads(); mixer_phase(P, lq, lds, ldsl, MISC, (gu32*)(P->ws + WS_CTL) + 2048, tid, wave, lane); } } SEAM(pb + 3);
        if (EN(6) && IN(pb + 4)) { PH_IDS finalize_phase(fresh_args(), lq, GW, NGW, lane); if (DBL & 129) finalize_phase(fresh_args(), lq, GW, NGW, lane); } SEAM(pb + 4);
        if (EN(7) && IN(pb + 5)) {
            const int lq = opaque_s(l); KArgs P = fresh_args(); unsigned char* ws = P->ws; float* xres = (float*)(ws + WS_XRES);
            pg8::Gemm g{(const pg8::bf16_t*)(ws + WS_MIX), (const pg8::bf16_t*)(ws + WS_WOUT + lq * SZ_WOUT), MROWS, DM, DM}; pg8::PanelOrder S; S.init(DM, G, bx, 1, 0, lq != DEPTH - 1, DM / 64, WGM_OUT);
            pg8::EpiResGate E{xres, xres, (const float*)(ws + WS_MOD) + (size_t)lq * 3 * 24576, 2 * DM, 0, lq == 0, P->in[0], P->in[2], (float*)(ws + WS_PART)};
            if (DBL & 256) { pg8::EpiResGate E2 = E; E2.out = (float*)(ws + WS_OC); pg8::gemm_phase<pg8::EpiResGate, pg8::PanelOrder, true, true>(ldsl, g, S, E2, opaque_s(wave_s)); __syncthreads(); }
            pg8::gemm_phase<pg8::EpiResGate, pg8::PanelOrder, true, true>(ldsl, g, S, E, opaque_s(wave_s));
        } SEAM(pb + 5);
        if (EN(8) && IN(pb + 6)) { PH_IDS norm_phase(fresh_args(), lq, 3, 4, 0, lq == DEPTH - 1, lq < DEPTH - 1, GW, NGW, lane); if (DBL & 33) norm_phase(fresh_args(), lq, 3, 4, 0, lq == DEPTH - 1, lq < DEPTH - 1, GW, NGW, lane); } SEAM(pb + 6);
        if (EN(9) && IN(pb + 7)) {
            const int lq = opaque_s(l); KArgs P = fresh_args(); unsigned char* ws = P->ws;
            pg8::Gemm g{(const pg8::bf16_t*)(ws + WS_HX), (const pg8::bf16_t*)(ws + WS_WGU + lq * SZ_WGU), MROWS, 2 * DFF, DM}; pg8::PanelOrder S; S.init(2 * DFF, G, bx, lq == DEPTH - 1, 0, 0, 0, WGM_GU);
            pg8::EpiSwiglu E{(pg8::bf16_t*)(ws + WS_QKV), DFF};
            pg8::gemm_phase<pg8::EpiSwiglu, pg8::PanelOrder, true, true>(ldsl, g, S, E, opaque_s(wave_s));
            if (DBL & 8) { __syncthreads(); pg8::gemm_phase<pg8::EpiSwiglu, pg8::PanelOrder, true, true>(ldsl, g, S, E, opaque_s(wave_s)); }
        } SEAM(pb + 7);
        if (EN(10) && IN(pb + 8)) {
            const int lq = opaque_s(l); KArgs P = fresh_args(); unsigned char* ws = P->ws; float* xres = (float*)(ws + WS_XRES);
            pg8::Gemm g{(const pg8::bf16_t*)(ws + WS_QKV), (const pg8::bf16_t*)(ws + WS_WDN + lq * SZ_WDN), MROWS, DM, DFF}; pg8::PanelOrder S; S.init(DM, G, bx, 1, 0, lq != DEPTH - 1, DFF / 64, WGM_DN);
            pg8::EpiResGate E{xres, (lq == DEPTH - 1) ? P->out : xres, (const float*)(ws + WS_MOD) + (size_t)lq * 3 * 24576, 5 * DM, (lq == DEPTH - 1) ? 1 : 0, 0, nullptr, nullptr, (float*)(ws + WS_PART)};
            if (DBL & 512) { pg8::EpiResGate E2 = E; E2.out = (float*)(ws + WS_OC); E2.final_out = 0; pg8::gemm_phase<pg8::EpiResGate, pg8::PanelOrder, true, true>(ldsl, g, S, E2, opaque_s(wave_s)); __syncthreads(); }
            pg8::gemm_phase<pg8::EpiResGate, pg8::PanelOrder, true, true>(ldsl, g, S, E, opaque_s(wave_s));
        } SEAM(pb + 8);
    }
#undef IN
#undef SEAM
}

extern "C" void kernel_launch(void* const* d_in, const int* in_sizes, int n_in, void* d_out, int out_size, void* d_ws, size_t ws_size, hipStream_t stream) {
    static int grid = 0;
    if (grid == 0) {
        if (n_in != 19 || out_size != NB * SEQ * DM || ws_size < WS_END) { fprintf(stderr, "kernel_launch: shape/workspace mismatch: n_in %d out %d ws %zu (need %zu)\n", n_in, out_size, ws_size, (size_t)WS_END); grid = -1; return; }
        int dev = 0, cus = 0, per_cu = 0;
        if (hipGetDevice(&dev) != hipSuccess || hipDeviceGetAttribute(&cus, hipDeviceAttributeMultiprocessorCount, dev) != hipSuccess) { grid = -1; return; }
        if (hipFuncSetAttribute((const void*)hybrid_fwd, hipFuncAttributeMaxDynamicSharedMemorySize, LDS_BYTES) != hipSuccess) { fprintf(stderr, "kernel_launch: hipFuncSetAttribute failed\n"); grid = -1; return; }
        if (hipOccupancyMaxActiveBlocksPerMultiprocessor(&per_cu, (const void*)hybrid_fwd, NTHR, LDS_BYTES) != hipSuccess || per_cu < 1) { fprintf(stderr, "kernel_launch: occupancy query says %d\n", per_cu); }
        (void)hipGetLastError();
        grid = cus;
    }
    if (grid < 0) return;
    if (hipMemsetAsync((char*)d_ws + WS_CTL, 0, CTL_ZERO_BYTES, stream) != hipSuccess) return;
    Args a{};
    for (int i = 0; i < 19; ++i) a.in[i] = (const float*)d_in[i];
    a.out = (float*)d_out; a.ws = (unsigned char*)d_ws;
#if MK_ONE_LAUNCH
    a.ph_lo = 0; a.ph_hi = N_PHASES;
    hipLaunchKernelGGL(hybrid_fwd, dim3(grid), dim3(NTHR), LDS_BYTES, stream, a);
#else
    for (int p = 0; p < N_PHASES; ++p) { a.ph_lo = p; a.ph_hi = p + 1; hipLaunchKernelGGL(hybrid_fwd, dim3(grid), dim3(NTHR), LDS_BYTES, stream, a); }
#endif
}
```

```cpp
#include <hip/hip_runtime.h>
#include <cstdio>
#include <cstdint>
__device__ __forceinline__ int opaque_lane() { int t = __builtin_amdgcn_mbcnt_hi(~0u, __builtin_amdgcn_mbcnt_lo(~0u, 0u)); asm volatile("" : "+v"(t)); return t; }
__device__ __forceinline__ int opaque_s(int v) { asm volatile("" : "+s"(v)); return v; }
namespace pg8 {
#define PG8_LAS __attribute__((address_space(3)))
typedef unsigned short bf16_t;
typedef short bf16x8 __attribute__((ext_vector_type(8)));
typedef float f32x4 __attribute__((ext_vector_type(4)));
typedef unsigned u32x4 __attribute__((ext_vector_type(4)));
constexpr int BM = 256, BK = 64, HALF = 128, HTB = HALF * BK * 2  , STAGE_BYTES = 8 * HTB, NXCD = 8, WGM = 8;

__host__ __device__ __forceinline__ int lds_byte(int r, int c) { const int st = (r >> 4) * 2 + (c >> 5), rr = r & 15, cc = c & 31, ob = rr * 64 + cc * 2; return st * 1024 + (ob ^ (((ob >> 9) & 1) << 5)); }
__host__ __device__ __forceinline__ void stage_rc(int b, int& R, int& C) { const int st = b / 1024, sb = b % 1024, swz = sb ^ (((sb >> 9) & 1) << 5); R = (st >> 1) * 16 + swz / 64; C = (st & 1) * 32 + (swz % 64) / 2; }
__host__ __device__ __forceinline__ int perm32(int rho) { const int n = rho >> 4, i = rho & 15; return 8 * (i >> 2) + 4 * n + (i & 3); }

struct Unit { int pm, pn, kt0, nt, sl; };
struct Gemm { const bf16_t* A; const bf16_t* Bt; int M, N, K; };

struct StaticOrder {
    int nM, nN, nwg, G, c, wgm;
    __host__ __device__ void init(int M, int N, int G_, int c_, int wgm_ = WGM) { nM = M / BM; nN = N / BM; nwg = nM * nN; G = G_; c = c_; wgm = wgm_; }
    __host__ __device__ bool next(int i, Unit& u) const {
        const long L = (long)i * G + c; if (L >= nwg) return false;
        int wgid = (int)L; { const int q = nwg / NXCD, r = nwg % NXCD, xcd = wgid % NXCD, off = wgid / NXCD; wgid = (xcd < r ? xcd * (q + 1) : r * (q + 1) + (xcd - r) * q) + off; }
        const int nig = wgm * nN, gid = wgid / nig, fm = gid * wgm, gsz = (nM - fm) < wgm ? (nM - fm) : wgm;
        u.pm = fm + ((wgid % nig) % gsz); u.pn = (wgid % nig) / gsz; u.kt0 = 0; u.nt = 0; u.sl = 0; return true;
    }
    __device__ __forceinline__ void a_ready(const Unit&) const {}
    __device__ __forceinline__ void done(const Unit&) const {}
};
struct PanelOrder {
    StaticOrder so; int skip, extra, slices, ktiles;
    __host__ __device__ void init(int N, int G_, int c_, int skip_, int extra_, int slices_ = 0, int ktiles_ = 0, int wgm_ = WGM) { skip = skip_; extra = extra_; slices = slices_; ktiles = ktiles_; so.init(skip_ ? 16384 : 16896, N, G_, c_, wgm_); }
    __host__ __device__ bool next(int i, Unit& u) const {
        if (so.next(i, u)) { if (skip) u.pm += 1 + (u.pm >= 32 ? 1 : 0); return true; }
        const long L = (long)i * so.G + so.c - so.nwg;
        if (slices) { if (L >= 2 * so.nN * 8) return false;
            const int tl = (int)(L >> 3), sl = (int)(L & 7); u.pm = (tl >= so.nN) ? 33 : 0; u.pn = tl % so.nN;
            const int base = (ktiles / 16) * 2, rem = (ktiles - base * 8) / 2;
            u.nt = base + (sl < rem ? 2 : 0); u.kt0 = sl * base + 2 * (sl < rem ? sl : rem); u.sl = sl; return true; }
        if (L >= extra) return false;
        u.pm = (L >= 29) ? 33 : 0; u.pn = 21 + (int)(L % 29); u.kt0 = 0; u.nt = 0; u.sl = 0; return true;
    }
    __device__ __forceinline__ void a_ready(const Unit&) const {}
    __device__ __forceinline__ void done(const Unit&) const {}
};

typedef float f32x2 __attribute__((ext_vector_type(2)));
typedef __bf16 bf16x2_c __attribute__((ext_vector_type(2)));
__device__ __forceinline__ unsigned cvt_pk_bf16(float lo, float hi) { f32x2 v = {lo, hi}; bf16x2_c b = __builtin_convertvector(v, bf16x2_c); return __builtin_bit_cast(unsigned, b); }
constexpr int ROWS_B = 8448, PAN_B = 33;
struct EpiStore {
    static constexpr bool PERM = true, AFTER_DRAIN = false;
    bf16_t* O; int ldc;
    __device__ __forceinline__ void operator()(const f32x4 (&acc)[2][2][4][2], const Unit& u, int wr, int wc, int fr, int fq) const {
        const int row0 = u.pm * BM + wr * 64 + fr, col0 = u.pn * BM + wc * 32 + 8 * fq;
#pragma unroll
        for (int ai = 0; ai < 2; ++ai)
#pragma unroll
            for (int m = 0; m < 4; ++m) { bf16_t* rowp = O + (size_t)(row0 + ai * HALF + m * 16) * ldc + col0;
#pragma unroll
                for (int bj = 0; bj < 2; ++bj) { const f32x4 v0 = acc[ai][bj][m][0], v1 = acc[ai][bj][m][1];
                    u32x4 w; w.x = cvt_pk_bf16(v0[0], v0[1]); w.y = cvt_pk_bf16(v0[2], v0[3]); w.z = cvt_pk_bf16(v1[0], v1[1]); w.w = cvt_pk_bf16(v1[2], v1[3]);
                    *(u32x4*)(rowp + bj * HALF) = w; } }
    }
};
struct EpiInproj {
    static constexpr bool PERM = true, AFTER_DRAIN = false;
    bf16_t* O; int ldc; const float* aq_g; const float* ak_g; const float* dq_g; const float* dk_g; PG8_LAS float* xs;
    __device__ __forceinline__ void operator()(const f32x4 (&acc)[2][2][4][2], const Unit& u, int wr, int wc, int fr, int fq) const {
        const int row0 = u.pm * BM + wr * 64 + fr, col0 = u.pn * BM + wc * 32 + 8 * fq;
        const int pn = u.pn, kind = pn < 6 ? 1 : pn < 11 ? 2 : (pn == 21 || pn == 22) ? 3 : (pn >= 25 && pn < 30) ? 4 : 0;
        if (kind == 0) {
#pragma unroll
            for (int ai = 0; ai < 2; ++ai)
#pragma unroll
                for (int m = 0; m < 4; ++m) { bf16_t* rowp = O + (size_t)(row0 + ai * HALF + m * 16) * ldc + col0;
#pragma unroll
                    for (int bj = 0; bj < 2; ++bj) { const f32x4 v0 = acc[ai][bj][m][0], v1 = acc[ai][bj][m][1];
                        u32x4 w; w.x = cvt_pk_bf16(v0[0], v0[1]); w.y = cvt_pk_bf16(v0[2], v0[3]); w.z = cvt_pk_bf16(v1[0], v1[1]); w.w = cvt_pk_bf16(v1[2], v1[3]);
                        *(u32x4*)(rowp + bj * HALF) = w; } }
            return;
        }
        const bool isA = (kind & 1) != 0, isq = kind <= 2;
#pragma unroll
        for (int ai = 0; ai < 2; ++ai)
#pragma unroll
            for (int m = 0; m < 4; ++m)
#pragma unroll
                for (int bj = 0; bj < 2; ++bj) { const f32x4 a = acc[ai][bj][m][0], c = acc[ai][bj][m][1];
                    float q = (a[0] * a[0] + a[1] * a[1]) + (a[2] * a[2] + a[3] * a[3]) + (c[0] * c[0] + c[1] * c[1]) + (c[2] * c[2] + c[3] * c[3]);
                    q += __int_as_float(__builtin_amdgcn_ds_swizzle(__float_as_int(q), 0x1f | (16 << 10)));
                    { auto rr = __builtin_amdgcn_permlane32_swap(__float_as_uint(q), __float_as_uint(q), false, false); q = __uint_as_float(rr[0]) + __uint_as_float(rr[1]); }
                    if (fq == 0) xs[((((wr * 2 + ai) * 4 + m) * 16 + fr) * 2 + bj) * 4 + wc] = q; }
        asm volatile("s_waitcnt lgkmcnt(0)\n\ts_barrier" ::: "memory");
        const float* gp = kind == 1 ? aq_g : kind == 3 ? ak_g : kind == 2 ? dq_g : dk_g;
        const int ch = isA ? (32 * wc + 8 * fq) : ((32 * wc + 8 * fq) & 63);
        const f32x4 g0 = *(const f32x4*)(gp + ch), g1 = *(const f32x4*)(gp + ch + 4);
        const float qs = isq ? (isA ? 0.12751743f : 0.18033688f) : 1.0f;
        const bool latent = (u.pm % PAN_B) != 0;
        const bool use_row = isA ? (wc < 2) : ((wc & 1) == 0);
        float inv[4];
#pragma unroll
        for (int k = 0; k < 4; ++k) { const int p = ch / 2 + k;
            inv[k] = isA ? __builtin_amdgcn_exp2f(-(float)(2 * (p & 31)) * (13.287712379549449f / 64.0f)) : __builtin_amdgcn_exp2f(-(float)(2 * (p & 15)) * (13.287712379549449f / 32.0f)); }
#pragma unroll
        for (int ai = 0; ai < 2; ++ai)
#pragma unroll
            for (int m = 0; m < 4; ++m) {
                const int row = row0 + ai * HALF + m * 16, t = row % ROWS_B - 256;
                float cs[4], sn[4];
#pragma unroll
                for (int k = 0; k < 4; ++k) { cs[k] = 1.f; sn[k] = 0.f; }
                if (latent) { const float pos = (float)(use_row ? (t >> 6) : (t & 63));
#pragma unroll
                    for (int k = 0; k < 4; ++k) { float rv = pos * inv[k] * 0.15915494309189535f; rv -= floorf(rv); cs[k] = __builtin_amdgcn_cosf(rv); sn[k] = __builtin_amdgcn_sinf(rv); } }
                bf16_t* rowp = O + (size_t)row * ldc + col0;
#pragma unroll
                for (int bj = 0; bj < 2; ++bj) {
                    const f32x4 t4 = *(const PG8_LAS f32x4*)(xs + ((((wr * 2 + ai) * 4 + m) * 16 + fr) * 2 + bj) * 4);
                    const float ssum = isA ? ((t4[0] + t4[1]) + (t4[2] + t4[3])) : (wc < 2 ? t4[0] + t4[1] : t4[2] + t4[3]);
                    const float rstd = __builtin_amdgcn_rsqf(ssum * (isA ? 1.f / 128.f : 1.f / 64.f) + 1e-6f) * qs;
                    const f32x4 y0 = acc[ai][bj][m][0] * g0 * rstd, y1 = acc[ai][bj][m][1] * g1 * rstd;
                    u32x4 w;
                    w.x = cvt_pk_bf16(y0[0] * cs[0] - y0[1] * sn[0], y0[0] * sn[0] + y0[1] * cs[0]); w.y = cvt_pk_bf16(y0[2] * cs[1] - y0[3] * sn[1], y0[2] * sn[1] + y0[3] * cs[1]);
                    w.z = cvt_pk_bf16(y1[0] * cs[2] - y1[1] * sn[2], y1[0] * sn[2] + y1[1] * cs[2]); w.w = cvt_pk_bf16(y1[2] * cs[3] - y1[3] * sn[3], y1[2] * sn[3] + y1[3] * cs[3]);
                    *(u32x4*)(rowp + bj * HALF) = w; }
            }
    }
};
struct EpiSwiglu {
    static constexpr bool PERM = true, AFTER_DRAIN = false;
    bf16_t* O; int ldc;
    __device__ __forceinline__ void operator()(const f32x4 (&acc)[2][2][4][2], const Unit& u, int wr, int wc, int fr, int fq) const {
        const int row0 = u.pm * BM + wr * 64 + fr, col0 = u.pn * HALF + wc * 32 + 8 * fq;
#pragma unroll
        for (int ai = 0; ai < 2; ++ai)
#pragma unroll
            for (int m = 0; m < 4; ++m) { bf16_t* rowp = O + (size_t)(row0 + ai * HALF + m * 16) * ldc + col0;
                float h[8];
#pragma unroll
                for (int n = 0; n < 2; ++n)
#pragma unroll
                    for (int i = 0; i < 4; ++i) { const float g = acc[ai][0][m][n][i], up = acc[ai][1][m][n][i];
                        h[n * 4 + i] = g * __builtin_amdgcn_rcpf(1.0f + __expf(-g)) * up; }
                u32x4 w; w.x = cvt_pk_bf16(h[0], h[1]); w.y = cvt_pk_bf16(h[2], h[3]); w.z = cvt_pk_bf16(h[4], h[5]); w.w = cvt_pk_bf16(h[6], h[7]);
                *(u32x4*)rowp = w; }
    }
};
typedef unsigned u32x2_e __attribute__((ext_vector_type(2)));
struct EpiResGate {
    static constexpr bool PERM = false, AFTER_DRAIN = false;
    const float* res; float* out; const float* modl; int goff; int final_out; int res_in; const float* xin; const float* cin; float* part;
    __device__ __forceinline__ void operator()(const f32x4 (&acc)[2][2][4][2], const Unit& u, int wr, int wc, int fr, int fq) const {
        const int b = u.pm / PAN_B, pl = u.pm % PAN_B, isctx = (pl == 0);
        if (final_out && isctx) return;
        const float* gate = modl + (isctx ? 2 : b) * 24576 + goff;
        const int col0 = u.pn * BM + wc * 32 + 4 * fq;
        f32x4 gv[2][2];
#pragma unroll
        for (int bj = 0; bj < 2; ++bj)
#pragma unroll
            for (int n = 0; n < 2; ++n) gv[bj][n] = *(const f32x4*)(gate + col0 + bj * HALF + n * 16);
        const float* rbase = isctx ? cin + (size_t)b * 256 * 4096 : xin + ((size_t)b * 8192 + (size_t)(pl - 1) * 256) * 4096;
        float* obase = out + ((size_t)b * 8192 + (size_t)(pl - 1) * 256) * 4096;
        const bf16_t* resb = (const bf16_t*)res + (size_t)u.pm * BM * 4096; bf16_t* outb = (bf16_t*)out + (size_t)u.pm * BM * 4096;
#define ERG_OFF(ai, m, bj, n) ((size_t)((ai) * HALF + wr * 64 + (m) * 16 + fr) * 4096 + col0 + (bj) * HALF + (n) * 16)
        if (u.nt) {
            float* pb = part + ((size_t)(u.sl * 512 + b * 256) * 4096);
#pragma unroll
            for (int ai = 0; ai < 2; ++ai)
#pragma unroll
                for (int m = 0; m < 4; ++m)
#pragma unroll
                    for (int bj = 0; bj < 2; ++bj)
#pragma unroll
                        for (int n = 0; n < 2; ++n) *(f32x4*)(pb + ERG_OFF(ai, m, bj, n)) = gv[bj][n] * acc[ai][bj][m][n];
            return;
        }
        if (res_in) {
#pragma unroll
            for (int ai = 0; ai < 2; ++ai)
#pragma unroll
                for (int mh = 0; mh < 2; ++mh) {
                    f32x4 x[2][2][2];
#pragma unroll
                    for (int m = 0; m < 2; ++m)
#pragma unroll
                        for (int bj = 0; bj < 2; ++bj)
#pragma unroll
                            for (int n = 0; n < 2; ++n) x[m][bj][n] = *(const f32x4*)(rbase + ERG_OFF(ai, 2 * mh + m, bj, n));
#pragma unroll
                    for (int m = 0; m < 2; ++m)
#pragma unroll
                        for (int bj = 0; bj < 2; ++bj)
#pragma unroll
                            for (int n = 0; n < 2; ++n) { const f32x4 y = x[m][bj][n] + gv[bj][n] * acc[ai][bj][2 * mh + m][n];
                                u32x2_e w; w.x = cvt_pk_bf16(y[0], y[1]); w.y = cvt_pk_bf16(y[2], y[3]); *(u32x2_e*)(outb + ERG_OFF(ai, 2 * mh + m, bj, n)) = w; }
                }
            return;
        }
        {
#pragma unroll
            for (int ai = 0; ai < 2; ++ai) {
                u32x2_e xb[4][2][2];
#pragma unroll
                for (int m = 0; m < 4; ++m)
#pragma unroll
                    for (int bj = 0; bj < 2; ++bj)
#pragma unroll
                        for (int n = 0; n < 2; ++n) xb[m][bj][n] = *(const u32x2_e*)(resb + ERG_OFF(ai, m, bj, n));
#pragma unroll
                for (int m = 0; m < 4; ++m)
#pragma unroll
                    for (int bj = 0; bj < 2; ++bj)
#pragma unroll
                        for (int n = 0; n < 2; ++n) { const u32x2_e t = xb[m][bj][n];
                            const f32x4 x = (f32x4){__uint_as_float(t.x << 16), __uint_as_float(t.x & 0xffff0000u), __uint_as_float(t.y << 16), __uint_as_float(t.y & 0xffff0000u)};
                            const f32x4 y = x + gv[bj][n] * acc[ai][bj][m][n];
                            if (final_out) *(f32x4*)(obase + ERG_OFF(ai, m, bj, n)) = y;
                            else { u32x2_e w; w.x = cvt_pk_bf16(y[0], y[1]); w.y = cvt_pk_bf16(y[2], y[3]); *(u32x2_e*)(outb + ERG_OFF(ai, m, bj, n)) = w; } }
            }
        }
#undef ERG_OFF
    }
};
template <class Epi, class Sched, bool ALIGN_EPI = false, bool SP2 = false>
__device__ __forceinline__ void gemm_phase(PG8_LAS unsigned char* lds, const Gemm g, const Sched& S, const Epi& E, const int wid) {
    const int lane = opaque_lane(), tid = wid * 64 + lane, wr = wid >> 2, wc = wid & 3, fr = lane & 15, fq = lane >> 4;
    const int K = g.K, nt = K / BK;
    unsigned voffA[2], voffB[2];
#pragma unroll
    for (int i = 0; i < 2; ++i) { int R, C; stage_rc(tid * 16 + i * 8192, R, C); const int Rb = Epi::PERM ? ((R & ~31) + perm32(R & 31)) : R;
        voffA[i] = (unsigned)(R * K + C) * 2u; voffB[i] = (unsigned)(Rb * K + C) * 2u; }
    const size_t kstep = (size_t)(BK * 2);
    const size_t hstep = (size_t)HALF * K * 2;
    const size_t tstep = 2 * hstep;
    const unsigned ldsw = (unsigned)wid * 1024u;
    const int aoff = lds_byte(wr * 64 + fr, fq * 8), boff = lds_byte(wc * 32 + fr, fq * 8);
#define PG8_SA(b, h) (((b) * 2 + (h)) * HTB)
#define PG8_SB(b, h) ((4 + (b) * 2 + (h)) * HTB)
#define PG8_STAGE(bufoff, gbase, voff) do { _Pragma("unroll") for (int _i = 0; _i < 2; ++_i) \
        __builtin_amdgcn_global_load_lds((const unsigned*)((const char*)(gbase) + (voff)[_i]), (PG8_LAS unsigned*)(lds + (bufoff) + ldsw + _i * 8192), 16, 0, 0); } while (0)
#define PG8_LDA(dst, b, h) do { _Pragma("unroll") for (int m = 0; m < 4; ++m) _Pragma("unroll") for (int k = 0; k < 2; ++k) dst[m][k] = *(const PG8_LAS bf16x8*)(lds + PG8_SA(b, h) + aoff + m * 2048 + k * 1024); } while (0)
#define PG8_LDB(dst, b, h) do { _Pragma("unroll") for (int n = 0; n < 2; ++n) _Pragma("unroll") for (int k = 0; k < 2; ++k) dst[n][k] = *(const PG8_LAS bf16x8*)(lds + PG8_SB(b, h) + boff + n * 2048 + k * 1024); } while (0)
#define PG8_MMA(ai, bj, At, Bt) do { __builtin_amdgcn_s_setprio(1); _Pragma("unroll") for (int m = 0; m < 4; ++m) _Pragma("unroll") for (int n = 0; n < 2; ++n) _Pragma("unroll") for (int k = 0; k < 2; ++k) \
        acc[ai][bj][m][n] = __builtin_amdgcn_mfma_f32_16x16x32_bf16(Bt[n][k], At[m][k], acc[ai][bj][m][n], 0, 0, 0); __builtin_amdgcn_s_setprio(0); } while (0)
#define PG8_WAIT_V(n) asm volatile("s_waitcnt vmcnt(" #n ")" ::: "memory")
#define PG8_WAIT_L(n) asm volatile("s_waitcnt lgkmcnt(" #n ")" ::: "memory")
#define PG8_BAR __builtin_amdgcn_s_barrier()
#define PG8_SCHED __builtin_amdgcn_sched_barrier(0)
    Unit cur, nxt; int ui = 0;
    if (!S.next(0, cur)) return;
    f32x4 acc[2][2][4][2];
#pragma unroll
    for (int a = 0; a < 2; ++a)
#pragma unroll
        for (int b = 0; b < 2; ++b)
#pragma unroll
            for (int m = 0; m < 4; ++m)
#pragma unroll
                for (int n = 0; n < 2; ++n) acc[a][b][m][n] = (f32x4){0.f, 0.f, 0.f, 0.f};
    bf16x8 At[4][2], B0[2][2], B1[2][2];
    const char* cA = (const char*)g.A + (size_t)cur.pm * tstep + (size_t)cur.kt0 * kstep; const char* cB = (const char*)g.Bt + (size_t)cur.pn * tstep + (size_t)cur.kt0 * kstep;
    int cnt = cur.nt ? cur.nt : nt;
    S.a_ready(cur);
    if constexpr (SP2) {
        PG8_STAGE(PG8_SB(0, 0), cB, voffB); PG8_STAGE(PG8_SB(0, 1), cB + hstep, voffB); PG8_STAGE(PG8_SA(0, 0), cA, voffA); PG8_STAGE(PG8_SA(0, 1), cA + hstep, voffA);
        if (wr == 1) PG8_BAR;
        PG8_WAIT_V(2); PG8_BAR;
        PG8_STAGE(PG8_SB(1, 0), cB + kstep, voffB); PG8_STAGE(PG8_SA(1, 0), cA + kstep, voffA); PG8_STAGE(PG8_SB(1, 1), cB + hstep + kstep, voffB);
        PG8_WAIT_V(6); PG8_BAR;
    } else {
        PG8_STAGE(PG8_SB(0, 0), cB, voffB); PG8_STAGE(PG8_SA(0, 0), cA, voffA); PG8_STAGE(PG8_SB(0, 1), cB + hstep, voffB); PG8_STAGE(PG8_SA(0, 1), cA + hstep, voffA);
        if (wr == 1) PG8_BAR;
        PG8_WAIT_V(4); PG8_BAR;
        PG8_STAGE(PG8_SB(1, 0), cB + kstep, voffB); PG8_STAGE(PG8_SA(1, 0), cA + kstep, voffA); PG8_STAGE(PG8_SB(1, 1), cB + hstep + kstep, voffB);
        PG8_WAIT_V(6); PG8_BAR;
    }
    for (;;) {
        const bool has_next = S.next(ui + 1, nxt);
        const char* nA = has_next ? (const char*)g.A + (size_t)nxt.pm * tstep + (size_t)nxt.kt0 * kstep : cA; const char* nB = has_next ? (const char*)g.Bt + (size_t)nxt.pn * tstep + (size_t)nxt.kt0 * kstep : cB;
        for (int t = 0; t < cnt; t += 2) {
            const bool last = (t == cnt - 2);
            const char* a1 = cA + (size_t)(t + 1) * kstep;
            const char* a2 = last ? nA : cA + (size_t)(t + 2) * kstep; const char* b2 = last ? nB : cB + (size_t)(t + 2) * kstep;
            const char* a3 = a2 + kstep; const char* b3 = b2 + kstep;
            if (last && has_next) S.a_ready(nxt);
            if constexpr (SP2) {
            PG8_LDB(B0, 0, 0); PG8_LDB(B1, 0, 1); PG8_SCHED; PG8_LDA(At, 0, 0); PG8_STAGE(PG8_SA(1, 1), a1 + hstep, voffA);
            PG8_WAIT_V(8); PG8_WAIT_L(0); PG8_BAR; PG8_MMA(0, 0, At, B0); PG8_MMA(0, 1, At, B1); PG8_BAR; PG8_SCHED;
            PG8_LDA(At, 0, 1); PG8_STAGE(PG8_SB(0, 0), b2, voffB); PG8_STAGE(PG8_SB(0, 1), b2 + hstep, voffB); PG8_STAGE(PG8_SA(0, 0), a2, voffA);
            PG8_WAIT_V(8); PG8_WAIT_L(0); PG8_BAR; PG8_MMA(1, 0, At, B0); PG8_MMA(1, 1, At, B1); PG8_BAR; PG8_SCHED;
            PG8_LDB(B0, 1, 0); PG8_LDB(B1, 1, 1); PG8_SCHED; PG8_LDA(At, 1, 0); PG8_STAGE(PG8_SA(0, 1), a2 + hstep, voffA);
            PG8_WAIT_V(8); PG8_WAIT_L(0); PG8_BAR; PG8_MMA(0, 0, At, B0); PG8_MMA(0, 1, At, B1); PG8_BAR; PG8_SCHED;
            PG8_LDA(At, 1, 1); PG8_STAGE(PG8_SB(1, 0), b3, voffB); PG8_STAGE(PG8_SB(1, 1), b3 + hstep, voffB); PG8_STAGE(PG8_SA(1, 0), a3, voffA);
            PG8_WAIT_V(8); PG8_WAIT_L(0); PG8_BAR; PG8_MMA(1, 0, At, B0); PG8_MMA(1, 1, At, B1); PG8_BAR; PG8_SCHED;
            } else {
            PG8_LDB(B0, 0, 0); PG8_SCHED; PG8_LDA(At, 0, 0); PG8_STAGE(PG8_SA(1, 1), a1 + hstep, voffA);
            PG8_WAIT_L(8); PG8_BAR; PG8_WAIT_L(0); PG8_MMA(0, 0, At, B0); PG8_BAR; PG8_SCHED;
            PG8_LDB(B1, 0, 1); PG8_STAGE(PG8_SB(0, 0), b2, voffB);
            PG8_BAR; PG8_WAIT_L(0); PG8_MMA(0, 1, At, B1); PG8_BAR;
            PG8_LDA(At, 0, 1); PG8_STAGE(PG8_SA(0, 0), a2, voffA);
            PG8_BAR; PG8_WAIT_L(0); PG8_MMA(1, 0, At, B0); PG8_BAR; PG8_SCHED;
            PG8_STAGE(PG8_SB(0, 1), b2 + hstep, voffB);
            PG8_WAIT_V(6); PG8_BAR; PG8_MMA(1, 1, At, B1); PG8_BAR;
            PG8_LDB(B0, 1, 0); PG8_SCHED; PG8_LDA(At, 1, 0); PG8_STAGE(PG8_SA(0, 1), a2 + hstep, voffA);
            PG8_WAIT_L(8); PG8_BAR; PG8_WAIT_L(0); PG8_MMA(0, 0, At, B0); PG8_BAR; PG8_SCHED;
            PG8_LDB(B1, 1, 1); PG8_STAGE(PG8_SB(1, 0), b3, voffB);
            PG8_BAR; PG8_WAIT_L(0); PG8_MMA(0, 1, At, B1); PG8_BAR;
            PG8_LDA(At, 1, 1); PG8_STAGE(PG8_SA(1, 0), a3, voffA);
            PG8_BAR; PG8_WAIT_L(0); PG8_MMA(1, 0, At, B0); PG8_BAR; PG8_SCHED;
            PG8_STAGE(PG8_SB(1, 1), b3 + hstep, voffB);
            PG8_WAIT_V(6); PG8_BAR; PG8_MMA(1, 1, At, B1); PG8_BAR;
            }
        }
        if constexpr (ALIGN_EPI) { if (wr == 0) PG8_BAR; }
        if constexpr (!Epi::AFTER_DRAIN) { E(acc, cur, wr, wc, fr, fq); S.done(cur); }
        if (!has_next) break;
#pragma unroll
        for (int a = 0; a < 2; ++a)
#pragma unroll
            for (int b = 0; b < 2; ++b)
#pragma unroll
                for (int m = 0; m < 4; ++m)
#pragma unroll
                    for (int n = 0; n < 2; ++n) acc[a][b][m][n] = (f32x4){0.f, 0.f, 0.f, 0.f};
        cur = nxt; cA = nA; cB = nB; ++ui; cnt = cur.nt ? cur.nt : nt;
        if constexpr (ALIGN_EPI) { if (wr == 1) PG8_BAR; }
    }
    PG8_WAIT_V(0);
    if constexpr (!ALIGN_EPI) { if (wr == 0) PG8_BAR; }
    PG8_BAR;
    if constexpr (Epi::AFTER_DRAIN) { E.fused(acc, cur, wr, wc, fr, fq, lds, wid, lane); S.done(cur); }
#undef PG8_SA
#undef PG8_SB
#undef PG8_STAGE
#undef PG8_LDA
#undef PG8_LDB
#undef PG8_MMA
#undef PG8_WAIT_V
#undef PG8_WAIT_L
#undef PG8_BAR
#undef PG8_SCHED
}
}
namespace att {
typedef unsigned short bf16_t;
using bf16x8 = __attribute__((ext_vector_type(8))) short;
using s16x4  = __attribute__((ext_vector_type(4))) short;
using f32x16 = __attribute__((ext_vector_type(16))) float;
using u32x4  = __attribute__((ext_vector_type(4))) unsigned;
constexpr int NW = 8, QBLK = 32, KVBLK = 64, LDX = 12800;
constexpr float THR = 8.f;
constexpr int SHM_V = KVBLK * 128 * 2, SHM_K = KVBLK * 128 * 2, SHM_ATTN = 2 * SHM_V + 2 * SHM_K + NW * 64 * 4;
#define ATT_SBAR() __builtin_amdgcn_sched_barrier(0)
__device__ __forceinline__ int crow(int r, int hi) { return (r & 3) + 8 * (r >> 2) + 4 * hi; }
__device__ __forceinline__ unsigned cvtpk(float lo, float hi) { unsigned r; asm volatile("v_cvt_pk_bf16_f32 %0, %1, %2" : "=v"(r) : "v"(lo), "v"(hi)); return r; }
template <int DQK> __device__ __forceinline__ int kswz(int row, int colB) {
  if constexpr (DQK == 128) return row * 256 + (colB ^ ((row & 7) << 4));
  else return (row >> 1) * 256 + ((((row & 1) << 7) + colB) ^ (((row >> 1) & 7) << 4));
}

__device__ __forceinline__ void partialSM(f32x16&) {}
__device__ __forceinline__ void finishSM(f32x16& p0, f32x16& p1, float& l_reg, bf16x8& pa0, bf16x8& pa1, bf16x8& pa2, bf16x8& pa3) {
#pragma unroll
  for (int r = 0; r < 16; ++r) p0[r] = __builtin_amdgcn_exp2f(p0[r]);
#pragma unroll
  for (int r = 0; r < 16; ++r) p1[r] = __builtin_amdgcn_exp2f(p1[r]);
  float ps = 0;
#pragma unroll
  for (int r = 0; r < 16; ++r) ps += p0[r];
#pragma unroll
  for (int r = 0; r < 16; ++r) ps += p1[r];
  l_reg += ps;
#define ATT_PK4(P, BASE, OUT) do { unsigned a0 = cvtpk(P[BASE + 0], P[BASE + 1]), a1 = cvtpk(P[BASE + 2], P[BASE + 3]);   \
    unsigned b0 = cvtpk(P[BASE + 4], P[BASE + 5]), b1 = cvtpk(P[BASE + 6], P[BASE + 7]);                              \
    auto r0 = __builtin_amdgcn_permlane32_swap(a0, b0, false, false); auto r1 = __builtin_amdgcn_permlane32_swap(a1, b1, false, false); \
    u32x4 w = {r0[0], r1[0], r0[1], r1[1]}; OUT = *reinterpret_cast<bf16x8*>(&w); } while (0)
  ATT_PK4(p0, 0, pa0); ATT_PK4(p0, 8, pa1); ATT_PK4(p1, 0, pa2); ATT_PK4(p1, 8, pa3);
#undef ATT_PK4
}
template <int DQK> __device__ __forceinline__ void qkt(f32x16& p0, f32x16& p1, const char* Ks, const bf16x8* qr, int r32, int hi) {
  constexpr int N = DQK / 16;
  bf16x8 k0[2], k1[2];
  { const int cb = (hi * 8) * 2; k0[0] = *reinterpret_cast<const bf16x8*>(Ks + kswz<DQK>(r32, cb)); k1[0] = *reinterpret_cast<const bf16x8*>(Ks + kswz<DQK>(32 + r32, cb)); }
  p0 = f32x16{}; p1 = f32x16{};
#pragma unroll
  for (int d0 = 0; d0 < N; ++d0) {
    if (d0 + 1 < N) { const int cb = ((d0 + 1) * 16 + hi * 8) * 2;
      k0[(d0 + 1) & 1] = *reinterpret_cast<const bf16x8*>(Ks + kswz<DQK>(r32, cb)); k1[(d0 + 1) & 1] = *reinterpret_cast<const bf16x8*>(Ks + kswz<DQK>(32 + r32, cb)); }
    __builtin_amdgcn_sched_barrier(0x406);
    p0 = __builtin_amdgcn_mfma_f32_32x32x16_bf16(k0[d0 & 1], qr[d0], p0, 0, 0, 0);
    p1 = __builtin_amdgcn_mfma_f32_32x32x16_bf16(k1[d0 & 1], qr[d0], p1, 0, 0, 0);
    __builtin_amdgcn_sched_barrier(0x406);
  }
}
__device__ __forceinline__ int v_st(int k, int c) { const int kk = (k & ~0xC) | ((k & 4) << 1) | ((k & 8) >> 1); return ((kk >> 3) * 4 + (c >> 5)) * 512 + ((kk & 7) * 32 + (c & 31)) * 2; }
__device__ __forceinline__ int v_rd_base(int lane) { return ((lane & 3) << 3) | (((lane >> 2) & 3) << 6) | (((lane >> 4) & 1) << 5) | (((lane >> 5) & 1) << 8); }
constexpr int v_rd_off(int d0, int ks, int half) { return d0 * 512 + ks * 4096 + half * 2048; }
template <int OFF> __device__ __forceinline__ s16x4 tr_read(int vb) {
  s16x4 r; asm volatile("ds_read_b64_tr_b16 %0, %1 offset:%2" : "=&v"(r) : "v"(vb), "i"(OFF) : "memory"); return r;
}
template <int D0> __device__ __forceinline__ void pv_one(f32x16& od, int vb, bf16x8 pa0, bf16x8 pa1, bf16x8 pa2, bf16x8 pa3) {
  const s16x4 l0 = tr_read<v_rd_off(D0, 0, 0)>(vb), h0 = tr_read<v_rd_off(D0, 0, 1)>(vb), l1 = tr_read<v_rd_off(D0, 1, 0)>(vb), h1 = tr_read<v_rd_off(D0, 1, 1)>(vb);
  const s16x4 l2 = tr_read<v_rd_off(D0, 2, 0)>(vb), h2 = tr_read<v_rd_off(D0, 2, 1)>(vb), l3 = tr_read<v_rd_off(D0, 3, 0)>(vb), h3 = tr_read<v_rd_off(D0, 3, 1)>(vb);
  asm volatile("s_waitcnt lgkmcnt(0)" ::: "memory"); ATT_SBAR();
#define ATT_PK(L, H) (bf16x8){L[0], L[1], L[2], L[3], H[0], H[1], H[2], H[3]}
  od = __builtin_amdgcn_mfma_f32_32x32x16_bf16(pa0, ATT_PK(l0, h0), od, 0, 0, 0);
  od = __builtin_amdgcn_mfma_f32_32x32x16_bf16(pa1, ATT_PK(l1, h1), od, 0, 0, 0);
  od = __builtin_amdgcn_mfma_f32_32x32x16_bf16(pa2, ATT_PK(l2, h2), od, 0, 0, 0);
  od = __builtin_amdgcn_mfma_f32_32x32x16_bf16(pa3, ATT_PK(l3, h3), od, 0, 0, 0);
#undef ATT_PK
}
__device__ __forceinline__ void pv_d0(f32x16* o, int vb, bf16x8 pa0, bf16x8 pa1, bf16x8 pa2, bf16x8 pa3) {
  pv_one<0>(o[0], vb, pa0, pa1, pa2, pa3); pv_one<1>(o[1], vb, pa0, pa1, pa2, pa3); pv_one<2>(o[2], vb, pa0, pa1, pa2, pa3); pv_one<3>(o[3], vb, pa0, pa1, pa2, pa3);
}

constexpr int SLOT = 32768, SLOT_V = 16384, NSLOT = 3, ATT_LDS = NSLOT * SLOT + NW * 64 * 4;
__device__ __forceinline__ void glds16(const void* sbase, unsigned voff, unsigned lds_dst) {
  unsigned keep;
  asm volatile("s_mov_b32 %0, m0\n\ts_mov_b32 m0, %3\n\ts_nop 0\n\tglobal_load_lds_dwordx4 %1, %2\n\ts_mov_b32 m0, %0" : "=&s"(keep) : "v"(voff), "s"(sbase), "s"(lds_dst) : "memory");
}
#define ATT_WAIT_BAR() asm volatile("s_waitcnt vmcnt(0) lgkmcnt(0)\n\ts_barrier" ::: "memory")
template <int DQK, bool OUTF32>
__device__ __forceinline__ void attn_body(const bf16_t* __restrict__ Qb, const bf16_t* __restrict__ Kh, const bf16_t* __restrict__ Vh,
                                          void* __restrict__ Ob, const int ldo, const int seq, char* lds, const int wid) {
  const int lane = opaque_lane(), r32 = lane & 31, hi = lane >> 5;
  const unsigned lds0 = (unsigned)(uintptr_t)lds;
  float* li_l = (float*)(lds + NSLOT * SLOT) + wid * 64;
  float l_reg = 0; f32x16 o[4] = {}; bf16x8 qr[DQK / 16];
  const bf16_t* Qw = Qb + (long)(wid * QBLK + r32) * LDX + hi * 8;
#pragma unroll
  for (int d0 = 0; d0 < DQK / 16; ++d0) qr[d0] = *reinterpret_cast<const bf16x8*>(Qw + d0 * 16);
  unsigned offK[2], offV[2];
  if constexpr (DQK == 128) {
#pragma unroll
    for (int i = 0; i < 2; ++i) { const int row = 4 * (2 * wid + i) + (lane >> 4), colB = ((lane & 15) * 16) ^ ((row & 7) << 4); offK[i] = (unsigned)(row * (LDX * 2) + colB); }
  } else {
    const int sr = 4 * wid + (lane >> 4), x = ((lane & 15) * 16) ^ ((sr & 7) << 4), row = 2 * sr + (x >> 7); offK[0] = (unsigned)(row * (LDX * 2) + (x & 127)); offK[1] = 0;
  }
#pragma unroll
  for (int i = 0; i < 2; ++i) { const int sub = 2 * (2 * wid + i) + (lane >> 5), kk = (sub >> 2) * 8 + ((lane & 31) >> 2), c = (sub & 3) * 32 + (lane & 3) * 8;
    const int k = (kk & ~0xC) | ((kk & 4) << 1) | ((kk & 8) >> 1); offV[i] = (unsigned)(k * (LDX * 2) + c * 2); }
  const unsigned dstK = lds0 + (DQK == 128 ? 2 * wid : wid) * 1024, dstV = lds0 + SLOT_V + 2 * wid * 1024;
#define ATT_DMA(t, slotoff) do { const char* kb_ = (const char*)Kh + (size_t)(t) * (KVBLK * LDX * 2); const char* vb_ = (const char*)Vh + (size_t)(t) * (KVBLK * LDX * 2); \
    glds16(kb_, offK[0], dstK + (slotoff)); if constexpr (DQK == 128) glds16(kb_, offK[1], dstK + (slotoff) + 1024); \
    glds16(vb_, offV[0], dstV + (slotoff)); glds16(vb_, offV[1], dstV + (slotoff) + 1024); } while (0)
#define ATT_NEXT(so) ((so) == 2 * SLOT ? 0 : (so) + SLOT)
  const int vb0 = (int)lds0 + SLOT_V + v_rd_base(lane);
  f32x16 pA0, pA1, pB0, pB1; bf16x8 pa0, pa1, pa2, pa3; const int NT = seq / KVBLK;
  ATT_DMA(0, 0); ATT_DMA(1, SLOT);
  if constexpr (DQK == 128) asm volatile("s_waitcnt vmcnt(4)\n\ts_barrier" ::: "memory"); else asm volatile("s_waitcnt vmcnt(3)\n\ts_barrier" ::: "memory");
  qkt<DQK>(pA0, pA1, lds, qr, r32, hi); partialSM(pA0);
  ATT_WAIT_BAR();
  int so_p = 0, so_c = SLOT, so_n = 2 * SLOT;
  for (int j = 1; j + 1 < NT; j += 2) {
    ATT_SBAR(); qkt<DQK>(pB0, pB1, lds + so_c, qr, r32, hi);
    if (j + 1 < NT) ATT_DMA(j + 1, so_n);
    finishSM(pA0, pA1, l_reg, pa0, pa1, pa2, pa3); ATT_SBAR();
    pv_d0(o, vb0 + so_p, pa0, pa1, pa2, pa3); partialSM(pB0);
    ATT_WAIT_BAR();
    so_p = so_c; so_c = ATT_NEXT(so_c); so_n = ATT_NEXT(so_n);
    ATT_SBAR(); qkt<DQK>(pA0, pA1, lds + so_c, qr, r32, hi);
    if (j + 2 < NT) ATT_DMA(j + 2, so_n);
    finishSM(pB0, pB1, l_reg, pa0, pa1, pa2, pa3); ATT_SBAR();
    pv_d0(o, vb0 + so_p, pa0, pa1, pa2, pa3); partialSM(pA0);
    ATT_WAIT_BAR();
    so_p = so_c; so_c = ATT_NEXT(so_c); so_n = ATT_NEXT(so_n);
  }
  ATT_SBAR(); qkt<DQK>(pB0, pB1, lds + so_c, qr, r32, hi);
  finishSM(pA0, pA1, l_reg, pa0, pa1, pa2, pa3); ATT_SBAR();
  pv_d0(o, vb0 + so_p, pa0, pa1, pa2, pa3); partialSM(pB0);
  finishSM(pB0, pB1, l_reg, pa0, pa1, pa2, pa3); ATT_SBAR();
  pv_d0(o, vb0 + so_c, pa0, pa1, pa2, pa3);
  { auto rr = __builtin_amdgcn_permlane32_swap(__float_as_uint(l_reg), __float_as_uint(l_reg), false, false); l_reg = __uint_as_float(rr[0]) + __uint_as_float(rr[1]); }
  if (hi == 0) li_l[r32] = l_reg; asm volatile("s_waitcnt lgkmcnt(0)" ::: "memory");
  float rli[16];
#pragma unroll
  for (int r = 0; r < 16; ++r) rli[r] = __builtin_amdgcn_rcpf(li_l[crow(r, hi)]);
  if constexpr (OUTF32) {
    bf16_t* Ow = (bf16_t*)Ob + (long)(wid * QBLK) * ldo;
    const bool odd = (r32 & 1) != 0;
#pragma unroll
    for (int r = 0; r < 16; r += 2) { const int orow = crow(r, hi) + (odd ? 1 : 0);
#pragma unroll
      for (int d0 = 0; d0 < 4; ++d0) { const float xa = o[d0][r] * rli[r], xb = o[d0][r + 1] * rli[r + 1];
        const float send = odd ? xa : xb, keep = odd ? xb : xa;
        const float recv = __int_as_float(__builtin_amdgcn_mov_dpp(__float_as_int(send), 0xB1, 0xf, 0xf, true));
        const unsigned w = pg8::cvt_pk_bf16(odd ? recv : keep, odd ? keep : recv);
        *(unsigned*)(Ow + (long)orow * ldo + d0 * 32 + (r32 & ~1)) = w; } }
  } else {
    bf16_t* Ow = (bf16_t*)Ob + (long)(wid * QBLK) * ldo;
#pragma unroll
    for (int r = 0; r < 16; ++r) { const int orow = crow(r, hi);
#pragma unroll
      for (int d0 = 0; d0 < 4; ++d0) Ow[(long)orow * ldo + d0 * 32 + r32] = (bf16_t)(cvtpk(o[d0][r] * rli[r], 0.f) & 0xffffu); }
  }
#undef ATT_DMA
#undef ATT_NEXT
}
}
constexpr int NWAVES = 8, NTHR = 512;
constexpr int DM = 4096, NB = 2, SEQ = 8192, CTX = 256, DEPTH = 2, DFF = 11008, INC = 12800;
constexpr int ROWS_B = 8448, MROWS = NB * ROWS_B, NCHUNK = MROWS / 16;
constexpr int C_AQ = 0, C_CQ = 1536, C_BQ = 2816, C_BG = 4096, C_AK = 5376, C_AV = 5888, C_CK = 6400, C_CV = 7680, C_BI = 8960, C_BFF = 10240, C_BFB = 11520;
constexpr int BW = 1280;
constexpr float EPS = 1e-6f;
#ifndef DBL
#define DBL 0
#endif
#define WGM_IN 4
#define WGM_OUT 4
#define WGM_GU 4
#define WGM_DN 4
#ifndef MK_ONE_LAUNCH
#define MK_ONE_LAUNCH 1
#endif
constexpr int N_PHASES = 2 + 9 * DEPTH;

constexpr size_t MiB = 1u << 20;
constexpr size_t al256(size_t x) { return (x + 255) / 256 * 256; }
constexpr size_t WS_CTL = 0, CTL_ZERO_BYTES = 1 * MiB;
constexpr size_t SZ_WIN = (size_t)INC * DM * 2, SZ_WOUT = (size_t)DM * DM * 2, SZ_WGU = (size_t)2 * DFF * DM * 2, SZ_WDN = (size_t)DM * DFF * 2;
constexpr size_t WS_WIN = 1 * MiB, WS_WOUT = WS_WIN + DEPTH * SZ_WIN, WS_WGU = WS_WOUT + DEPTH * SZ_WOUT, WS_WDN = WS_WGU + DEPTH * SZ_WGU;
constexpr size_t WS_MODP = WS_WDN + DEPTH * SZ_WDN;
constexpr size_t WS_MOD = WS_MODP + (size_t)16 * 2 * 3 * 24576 * 4;
constexpr size_t WS_XRES = al256(WS_MOD + (size_t)2 * 3 * 24576 * 4);
constexpr size_t WS_HX = WS_XRES + (size_t)MROWS * DM * 4;
constexpr size_t WS_QKV = WS_HX + (size_t)MROWS * DM * 2;
constexpr size_t WS_MIX = WS_QKV + (size_t)MROWS * INC * 2;
constexpr size_t WS_OC = WS_MIX + (size_t)MROWS * DM * 2;
constexpr size_t SZ_SC = (size_t)MROWS * BW * 2;
constexpr size_t WS_QT = WS_OC + (size_t)MROWS * 2560 * 4;
constexpr size_t WS_KT = WS_QT + 2 * SZ_SC, WS_KP = WS_KT + 2 * SZ_SC, WS_VT = WS_KP + 2 * SZ_SC;
constexpr size_t WS_DEC = WS_VT + SZ_SC;
constexpr size_t WS_OB = WS_DEC + (size_t)2 * NCHUNK * BW * 4;
constexpr size_t WS_PART = WS_OB + (size_t)2 * MROWS * BW * 4;
constexpr size_t WS_END = WS_PART + (size_t)8 * 512 * DM * 4;
constexpr int CW_TMO = 0, CW_BAR = 4096, CW_WQ = 8192;

constexpr int RING_BYTES = 131072, MISC_OFF = RING_BYTES + 320, LDS_BYTES = 147456;

#define GAS __attribute__((address_space(1)))
#define LAS __attribute__((address_space(3)))
typedef unsigned short bf16;
typedef unsigned v4u __attribute__((ext_vector_type(4)));
typedef unsigned v2u __attribute__((ext_vector_type(2)));
typedef float f32x4 __attribute__((ext_vector_type(4)));
typedef float f32x2 __attribute__((ext_vector_type(2)));
typedef short bf16x8 __attribute__((ext_vector_type(8)));
typedef short s16x4 __attribute__((ext_vector_type(4)));
typedef GAS unsigned gu32;
#define RLX_AGENT __ATOMIC_RELAXED, __HIP_MEMORY_SCOPE_AGENT
#define LDS_WAIT() asm volatile("s_waitcnt lgkmcnt(0)" ::: "memory")
typedef __bf16 bf16x2_t __attribute__((ext_vector_type(2)));
__device__ __forceinline__ unsigned pkbf(float lo, float hi) { f32x2 v = {lo, hi}; bf16x2_t b = __builtin_convertvector(v, bf16x2_t); return __builtin_bit_cast(unsigned, b); }
__device__ __forceinline__ float bf2f(unsigned short h) { return __uint_as_float((unsigned)h << 16); }
__device__ __forceinline__ float bflo(unsigned w) { return __uint_as_float(w << 16); }
__device__ __forceinline__ float bfhi(unsigned w) { return __uint_as_float(w & 0xffff0000u); }
template <int M> __device__ __forceinline__ float swz_xor(float v) { return __int_as_float(__builtin_amdgcn_ds_swizzle(__float_as_int(v), 0x1f | (M << 10))); }
__device__ __forceinline__ float half_sum(float v) {
    v += swz_xor<1>(v); v += swz_xor<2>(v); v += swz_xor<4>(v); v += swz_xor<8>(v); v += swz_xor<16>(v);
    return v;
}
__device__ __forceinline__ float wave_sum(float v) {
    v = half_sum(v);
    auto rr = __builtin_amdgcn_permlane32_swap(__float_as_uint(v), __float_as_uint(v), false, false);
    return __uint_as_float(rr[0]) + __uint_as_float(rr[1]);
}
__device__ __forceinline__ float bcast_lane(float v, int j) { return __int_as_float(__builtin_amdgcn_readlane(__float_as_int(v), j)); }
__device__ __forceinline__ float silu_f(float x) { return x * __builtin_amdgcn_rcpf(1.0f + __expf(-x)); }
#define XB_TMO      128
#define XB_XCNT(j)  (256  + 64 * (j))
#define XB_XSUB(j)  (1280 + 64 * (j))
#define XB_XGEN(j)  (2304 + 64 * (j))
#define XB_TOP      3328
#define XB_TOPGEN   3392
#define XCD_BAR_WORDS 3456
#define XB_SPIN_CAP (1u << 18)

__device__ __forceinline__ unsigned xb_ld(unsigned* p)              { return __hip_atomic_load(p, __ATOMIC_RELAXED, __HIP_MEMORY_SCOPE_AGENT); }
__device__ __forceinline__ unsigned xb_add(unsigned* p, unsigned v) { return __hip_atomic_fetch_add(p, v, __ATOMIC_RELAXED, __HIP_MEMORY_SCOPE_AGENT); }
__device__ __forceinline__ unsigned xb_xcc_id() { return (unsigned)__builtin_amdgcn_s_getreg((3 << 11) | 20) & 0xFu; }
#define XB_SPIN(cond, bar) do { unsigned _sp = 0; while (cond) { __builtin_amdgcn_s_sleep(1); \
    if ((++_sp & 255u) == 0u) { if (xb_ld(&(bar)[XB_TMO])) break; if (_sp > XB_SPIN_CAP) { atomicAdd(&(bar)[XB_TMO], 1u); break; } } } } while (0)

struct XcdBarrier {
    unsigned* bar; unsigned x;
    volatile LAS unsigned* st;
};

__device__ __forceinline__ XcdBarrier xcd_barrier_post(unsigned* bar, volatile LAS unsigned* st) {
    XcdBarrier b; b.bar = bar; b.x = xb_xcc_id(); b.st = st;
    if (threadIdx.x == 0) (void)xb_add(&bar[XB_XCNT(b.x)], 1u);
    return b;
}
__device__ __forceinline__ void xcd_barrier_complete(unsigned* bar, unsigned x, unsigned& nloc, unsigned& nx) {
    const unsigned G = gridDim.x * gridDim.y * gridDim.z;
    unsigned sum, cnt, mine, sp = 0u;
    for (;;) {
        sum = 0u; cnt = 0u; mine = 0u;
#pragma unroll
        for (unsigned j = 0; j < 16; ++j) { const unsigned c = xb_ld(&bar[XB_XCNT(j)]); sum += c; cnt += (c > 0u) ? 1u : 0u; mine = (j == x) ? c : mine; }
        if (sum == G) break;
        __builtin_amdgcn_s_sleep(1);
        if ((++sp & 255u) == 0u) { if (xb_ld(&bar[XB_TMO])) break; if (sp > XB_SPIN_CAP) { atomicAdd(&bar[XB_TMO], 1u); break; } }
    }
    nloc = mine > 0u ? mine : 1u; nx = cnt > 0u ? cnt : 1u;
}

__device__ __forceinline__ void xcd_barrier(const XcdBarrier& b) {
    asm volatile("s_waitcnt vmcnt(0)" ::: "memory");
    __syncthreads();
    if (threadIdx.x == 0) {
        unsigned* bar = b.bar;
        __builtin_amdgcn_s_waitcnt(0);
        unsigned nloc = b.st[0], nx = b.st[1];
        if (nloc == 0u) { xcd_barrier_complete(bar, b.x, nloc, nx); b.st[0] = nloc; b.st[1] = nx; }
        const unsigned old = xb_add(&bar[XB_XSUB(b.x)], 1u);
        const unsigned gen = old / nloc;
        if (old + 1u == (gen + 1u) * nloc) {
            __builtin_amdgcn_fence(__ATOMIC_RELEASE, "agent");
            asm volatile("s_waitcnt vmcnt(0)" ::: "memory");
            const unsigned og = xb_add(&bar[XB_TOP], 1u);
            const unsigned tg = og / nx;
            if (og + 1u == (tg + 1u) * nx) xb_add(&bar[XB_TOPGEN], 1u);
            else XB_SPIN(xb_ld(&bar[XB_TOPGEN]) == tg, bar);
            __builtin_amdgcn_fence(__ATOMIC_ACQUIRE, "agent");
            xb_add(&bar[XB_XGEN(b.x)], 1u);
            asm volatile("s_waitcnt vmcnt(0)" ::: "memory");
        } else {
            XB_SPIN(xb_ld(&bar[XB_XGEN(b.x)]) == gen, bar);
            __builtin_amdgcn_fence(__ATOMIC_ACQUIRE, "agent");
            asm volatile("s_waitcnt vmcnt(0)" ::: "memory");
        }
    }
    __syncthreads();
}
struct Args { const float* in[19]; float* out; unsigned char* ws; int ph_lo, ph_hi; };
typedef const Args __attribute__((address_space(4)))* KArgs;
__device__ __forceinline__ KArgs fresh_args() { KArgs p = (KArgs)__builtin_amdgcn_kernarg_segment_ptr(); asm volatile("" : "+s"(p)); return p; }
constexpr int I_IN = 64 * 400, I_OUT = 64 * 128, I_G = 64 * 344, I_DN = 172 * 128, I_LAYER = I_IN + I_OUT + 2 * I_G + I_DN;
constexpr int CONV_PER_WAVE = 12, CONV_UNIT = 8 * CONV_PER_WAVE, N_CONV_UNITS = (DEPTH * I_LAYER - I_IN + CONV_UNIT - 1) / CONV_UNIT;
struct ConvItem { const float* src; bf16* dst; int N, pitch; };
__device__ __forceinline__ ConvItem conv_decode(KArgs P, int it, int lane) {
    const int l = it / I_LAYER; int r = it % I_LAYER; const float* W; bf16* WT; int N, pitch, k0, n0, drow;
    if (r < I_IN) { const int kb = r / 400, nb = r % 400; W = P->in[6] + (size_t)l * DM * INC; N = INC; WT = (bf16*)(P->ws + WS_WIN + l * SZ_WIN); pitch = DM; k0 = 64 * kb; n0 = 32 * nb; drow = n0; }
    else if ((r -= I_IN) < I_OUT) { const int kb = r / 128, nb = r % 128; W = P->in[7] + (size_t)l * DM * DM; N = DM; WT = (bf16*)(P->ws + WS_WOUT + l * SZ_WOUT); pitch = DM; k0 = 64 * kb; n0 = 32 * nb; drow = n0; }
    else if ((r -= I_OUT) < 2 * I_G) { const int up = r >= I_G; if (up) r -= I_G; const int kb = r / 344, nb = r % 344; n0 = 32 * nb;
        W = (up ? P->in[17] : P->in[16]) + (size_t)l * DM * DFF; N = DFF; WT = (bf16*)(P->ws + WS_WGU + l * SZ_WGU); pitch = DM; k0 = 64 * kb; drow = (n0 >> 7) * 256 + (n0 & 127) + (up ? 128 : 0); }
    else { r -= 2 * I_G; const int kb = r / 128, nb = r % 128; W = P->in[18] + (size_t)l * DFF * DM; N = DM; WT = (bf16*)(P->ws + WS_WDN + l * SZ_WDN); pitch = DFF; k0 = 64 * kb; n0 = 32 * nb; drow = n0; }
    ConvItem c; c.src = W + (size_t)(k0 + (lane >> 5)) * N + n0 + (lane & 31); c.dst = WT + (size_t)drow * pitch + k0; c.N = N; c.pitch = pitch; return c;
}
__device__ __forceinline__ void conv_load(float (&v)[32], const ConvItem& c) {
#pragma unroll
    for (int i = 0; i < 32; ++i) v[i] = __builtin_nontemporal_load(c.src + (size_t)(2 * i) * c.N);
}
__device__ __forceinline__ void conv_finish(const float (&v)[32], const ConvItem& c, LAS float* scr, int lane) {
#pragma unroll
    for (int i = 0; i < 32; ++i) scr[(2 * i + (lane >> 5)) * 33 + (lane & 31)] = v[i];
    LDS_WAIT(); asm volatile("" ::: "memory");
    const int cc = lane & 7;
#pragma unroll
    for (int j = 0; j < 4; ++j) { const int n = (lane >> 3) + 8 * j; const LAS float* s = scr + (8 * cc) * 33 + n;
        v4u o; o.x = pkbf(s[0 * 33], s[1 * 33]); o.y = pkbf(s[2 * 33], s[3 * 33]); o.z = pkbf(s[4 * 33], s[5 * 33]); o.w = pkbf(s[6 * 33], s[7 * 33]);
        __builtin_nontemporal_store(o, (GAS v4u*)(c.dst + (size_t)n * c.pitch + 8 * cc)); }
    LDS_WAIT(); asm volatile("" ::: "memory");
}
template <int NI> __device__ __forceinline__ void conv_run(KArgs P, int it0, int stride, int last, LAS float* scr, int lane) {
    float va[32], vb[32];
#define CONV_IT(k) (it0 + (k) * stride < last ? it0 + (k) * stride : last)
    ConvItem ca = conv_decode(P, CONV_IT(0), lane), cb = ca; conv_load(va, ca);
#pragma unroll 1
    for (int k = 0; k + 2 < NI; k += 2) {
        cb = conv_decode(P, CONV_IT(k + 1), lane); conv_load(vb, cb);
        conv_finish(va, ca, scr, lane);
        ca = conv_decode(P, CONV_IT(k + 2), lane); conv_load(va, ca);
        conv_finish(vb, cb, scr, lane);
    }
    if constexpr (NI % 2 == 0) { cb = conv_decode(P, CONV_IT(NI - 1), lane); conv_load(vb, cb); conv_finish(va, ca, scr, lane); conv_finish(vb, cb, scr, lane); }
    else conv_finish(va, ca, scr, lane);
#undef CONV_IT
}
__device__ __forceinline__ void p0_prologue(KArgs P, LAS unsigned char* lds, int gw, int NGW, int wave, int lane) {
    LAS float* scr = (LAS float*)(lds + wave * 16384);
    conv_run<13>(P, gw, NGW, I_IN - 1, scr, lane);
    for (int it = gw + 13 * NGW; it < I_IN; it += NGW) conv_run<1>(P, it, NGW, I_IN - 1, scr, lane);
    float* modp = (float*)(P->ws + WS_MODP);
    for (int it = gw; it < 2 * 96 * 16; it += NGW) {
        const int kp = it & 15, cb = (it >> 4) % 96, l = it / (16 * 96);
        f32x4 a0 = {0.f, 0.f, 0.f, 0.f}, a1 = a0, a2 = a0;
        const float* wb = P->in[4] + ((size_t)l * DM + 256 * kp) * 24576 + 256 * cb + 4 * lane;
        for (int kb = 0; kb < 4; ++kb) {
            const int k0 = 256 * kp + 64 * kb;
            const float s0 = silu_f(P->in[1][k0 + lane]), s1 = silu_f(P->in[1][DM + k0 + lane]), s2 = silu_f(P->in[3][k0 + lane]);
#pragma unroll 8
            for (int j = 0; j < 64; ++j) {
                const f32x4 w = *(const f32x4*)(wb + (size_t)(64 * kb + j) * 24576);
                a0 += w * bcast_lane(s0, j); a1 += w * bcast_lane(s1, j); a2 += w * bcast_lane(s2, j);
            }
        }
        float* o = modp + ((size_t)(kp * 2 + l) * 3) * 24576 + 256 * cb + 4 * lane;
        *(f32x4*)(o) = a0; *(f32x4*)(o + 24576) = a1; *(f32x4*)(o + 2 * 24576) = a2;
    }
}
__device__ __forceinline__ void p1_modreduce(KArgs P, int gtid, int NGT) {
    const float* modp = (const float*)(P->ws + WS_MODP); float* mod = (float*)(P->ws + WS_MOD);
    for (int i = gtid; i < 2 * 3 * 24576; i += NGT) {
        const int n = i % 24576, l = i / (3 * 24576);
        float s = P->in[5][l * 24576 + n];
#pragma unroll
        for (int kp = 0; kp < 16; ++kp) s += modp[(size_t)kp * (2 * 3 * 24576) + i];
        mod[i] = s;
    }
}
__device__ __forceinline__ void norm_phase(KArgs P, int l, int shift_idx, int scale_idx, int from_in, int skip_ctx, int add_parts, int gw, int ngw, int lane) {
    const bf16* xres = (const bf16*)(P->ws + WS_XRES); bf16* hx = (bf16*)(P->ws + WS_HX);
    const float* modl = (const float*)(P->ws + WS_MOD) + (size_t)l * 3 * 24576;
    for (int row = gw; row < MROWS; row += ngw) {
        const int b = row / ROWS_B, j = row % ROWS_B, rsel = (j < CTX) ? 2 : b;
        if (skip_ctx && j < CTX) continue;
        const f32x4* sh = (const f32x4*)(modl + rsel * 24576 + shift_idx * DM) + lane;
        const f32x4* sc = (const f32x4*)(modl + rsel * 24576 + scale_idx * DM) + lane;
        f32x4 v[16], sa1[8], sa0[8]; float ss = 0.f;
        if (from_in) { const float* src = (j < CTX) ? P->in[2] + ((size_t)b * CTX + j) * DM : P->in[0] + ((size_t)b * SEQ + (j - CTX)) * DM;
            const f32x4* xr = (const f32x4*)src + lane;
#pragma unroll
            for (int q = 0; q < 16; ++q) v[q] = xr[64 * q];
#pragma unroll
            for (int q = 0; q < 8; ++q) { sa1[q] = sc[64 * q]; sa0[q] = sh[64 * q]; } }
        else { const v2u* xb = (const v2u*)(xres + (size_t)row * DM) + lane; v2u t[16];
#pragma unroll
            for (int q = 0; q < 16; ++q) t[q] = __builtin_nontemporal_load(xb + 64 * q);
#pragma unroll
            for (int q = 0; q < 8; ++q) { sa1[q] = sc[64 * q]; sa0[q] = sh[64 * q]; }
#pragma unroll
            for (int q = 0; q < 16; ++q) v[q] = (f32x4){__uint_as_float(t[q].x << 16), __uint_as_float(t[q].x & 0xffff0000u), __uint_as_float(t[q].y << 16), __uint_as_float(t[q].y & 0xffff0000u)}; }
#pragma unroll
        for (int q = 0; q < 16; ++q) ss += (v[q].x * v[q].x + v[q].y * v[q].y) + (v[q].z * v[q].z + v[q].w * v[q].w);
        if (add_parts && j < CTX) {
            const f32x4* pp = (const f32x4*)(P->ws + WS_PART + ((size_t)(b * 256 + j) * DM) * 4) + lane; ss = 0.f;
#pragma unroll
            for (int q = 0; q < 16; ++q) { f32x4 t[8];
#pragma unroll
                for (int sl = 0; sl < 8; ++sl) t[sl] = pp[(size_t)sl * 512 * DM / 4 + 64 * q];
                f32x4 a = v[q];
#pragma unroll
                for (int sl = 0; sl < 8; ++sl) a += t[sl];
                v[q] = a; ss += (a.x * a.x + a.y * a.y) + (a.z * a.z + a.w * a.w); } }
        f32x4 sb1[8], sb0[8];
#pragma unroll
        for (int q = 0; q < 8; ++q) { sb1[q] = sc[64 * (q + 8)]; sb0[q] = sh[64 * (q + 8)]; }
        if ((from_in || add_parts) && j < CTX) { v2u* xo = (v2u*)(P->ws + WS_XRES + (size_t)row * DM * 2) + lane;
#pragma unroll
            for (int q = 0; q < 16; ++q) { v2u w; w.x = pkbf(v[q].x, v[q].y); w.y = pkbf(v[q].z, v[q].w); xo[64 * q] = w; } }
        const float rstd = __builtin_amdgcn_rsqf(wave_sum(ss) * (1.f / DM) + EPS);
        v2u* o = (v2u*)(hx + (size_t)row * DM) + lane;
#pragma unroll
        for (int q = 0; q < 8; ++q) { const f32x4 y = v[q] * rstd * (sa1[q] + 1.0f) + sa0[q];
            v2u w; w.x = pkbf(y.x, y.y); w.y = pkbf(y.z, y.w); o[64 * q] = w; }
#pragma unroll
        for (int q = 0; q < 8; ++q) { const f32x4 y = v[q + 8] * rstd * (sb1[q] + 1.0f) + sb0[q];
            v2u w; w.x = pkbf(y.x, y.y); w.y = pkbf(y.z, y.w); o[64 * (q + 8)] = w; }
    }
}
__device__ __forceinline__ void scanprep_phase(KArgs P, int l, int gtid, int NGT) {
    const bf16* qkv = (const bf16*)(P->ws + WS_QKV);
    bf16* QT = (bf16*)(P->ws + WS_QT); bf16* KT = (bf16*)(P->ws + WS_KT); bf16* KP = (bf16*)(P->ws + WS_KP); bf16* VT = (bf16*)(P->ws + WS_VT);
    float* DEC = (float*)(P->ws + WS_DEC);
    for (int idx = gtid; idx < NCHUNK * BW; idx += NGT) {
        const int ch = idx / BW, hd = idx % BW;
        float lbf = 0.f, lbb = 0.f;
        if (l > 0) { lbf = 1.f / (1.f + __expf(P->in[10][0 * 2 * BW + 0 * BW + hd] - P->in[10][1 * 2 * BW + 0 * BW + hd]));
                     lbb = 1.f / (1.f + __expf(P->in[10][0 * 2 * BW + 1 * BW + hd] - P->in[10][1 * 2 * BW + 1 * BW + hd])); }
        const bf16* base = qkv + (size_t)(ch * 16) * INC + hd;
        float q[16], gf[16], of[16], gb[16], ob[16]; unsigned short vv[16], rq[16], rzf[16], rzb[16];
#pragma unroll
        for (int t = 0; t < 16; ++t) { const bf16* rp = base + (size_t)t * INC; rq[t] = rp[C_BQ]; vv[t] = rp[C_BI]; rzf[t] = rp[C_BFF]; rzb[t] = rp[C_BFB]; }
        __builtin_amdgcn_sched_barrier(0);
#pragma unroll
        for (int t = 0; t < 16; ++t) {
            q[t] = silu_f(bf2f(rq[t]));
            const float zf = bf2f(rzf[t]), zb = bf2f(rzb[t]);
            const float ef = __expf(-zf), sf = __builtin_amdgcn_rcpf(1.f + ef); gf[t] = __logf(lbf + (1.f - lbf) * sf); of[t] = (1.f - lbf) * ef * sf;
            const float eb = __expf(-zb), sb = __builtin_amdgcn_rcpf(1.f + eb); gb[t] = __logf(lbb + (1.f - lbb) * sb); ob[t] = (1.f - lbb) * eb * sb;
        }
        const int dl = hd & 31, pos = (hd & ~31) + 8 * ((dl >> 2) & 3) + 4 * (dl >> 4) + (dl & 3);
        { float b = 0.f; float bt[16];
#pragma unroll
          for (int t = 0; t < 16; ++t) { b += gf[t]; bt[t] = b; }
          unsigned kp[8];
#pragma unroll
          for (int t = 0; t < 16; ++t) { const float e = __expf(bt[t]);
              QT[(size_t)(ch * 16 + t) * BW + pos] = (bf16)(pkbf(q[t] * e, 0.f) & 0xffffu);
              KT[(size_t)(ch * 16 + t) * BW + pos] = (bf16)(pkbf(of[t] * __expf(-bt[t]), 0.f) & 0xffffu); }
#pragma unroll
          for (int t = 0; t < 16; t += 2) kp[t >> 1] = pkbf(of[t] * __expf(b - bt[t]), of[t + 1] * __expf(b - bt[t + 1]));
          v4u* o = (v4u*)(KP + ((size_t)ch * BW + hd) * 16); o[0] = (v4u){kp[0], kp[1], kp[2], kp[3]}; o[1] = (v4u){kp[4], kp[5], kp[6], kp[7]};
          DEC[(size_t)ch * BW + hd] = __expf(b); }
        { float b = 0.f; float bt[16];
#pragma unroll
          for (int t = 15; t >= 0; --t) { b += gb[t]; bt[t] = b; }
          unsigned kp[8];
          bf16* QTb = QT + (size_t)MROWS * BW; bf16* KTb = KT + (size_t)MROWS * BW;
#pragma unroll
          for (int t = 0; t < 16; ++t) { const float e = __expf(bt[t]);
              QTb[(size_t)(ch * 16 + t) * BW + pos] = (bf16)(pkbf(q[t] * e, 0.f) & 0xffffu);
              KTb[(size_t)(ch * 16 + t) * BW + pos] = (bf16)(pkbf(ob[t] * __expf(-bt[t]), 0.f) & 0xffffu); }
#pragma unroll
          for (int t = 0; t < 16; t += 2) kp[t >> 1] = pkbf(ob[t] * __expf(b - bt[t]), ob[t + 1] * __expf(b - bt[t + 1]));
          v4u* o = (v4u*)(KP + (size_t)MROWS * BW + ((size_t)ch * BW + hd) * 16); o[0] = (v4u){kp[0], kp[1], kp[2], kp[3]}; o[1] = (v4u){kp[4], kp[5], kp[6], kp[7]};
          DEC[(size_t)NCHUNK * BW + (size_t)ch * BW + hd] = __expf(b); }
        { v4u* o = (v4u*)(VT + ((size_t)ch * BW + hd) * 16);
          o[0] = (v4u){vv[0] | ((unsigned)vv[1] << 16), vv[2] | ((unsigned)vv[3] << 16), vv[4] | ((unsigned)vv[5] << 16), vv[6] | ((unsigned)vv[7] << 16)};
          o[1] = (v4u){vv[8] | ((unsigned)vv[9] << 16), vv[10] | ((unsigned)vv[11] << 16), vv[12] | ((unsigned)vv[13] << 16), vv[14] | ((unsigned)vv[15] << 16)}; }
    }
}
constexpr int SC_SLOT = 17408, SC_NSLOT = 4;
__device__ __forceinline__ void sc_glds16(const void* sbase, unsigned voff, unsigned lds_dst) { unsigned keep;
  asm volatile("s_mov_b32 %0, m0\n\ts_mov_b32 m0, %3\n\ts_nop 0\n\tglobal_load_lds_dwordx4 %1, %2\n\ts_mov_b32 m0, %0" : "=&s"(keep) : "v"(voff), "s"(sbase), "s"(lds_dst) : "memory"); }
__device__ __forceinline__ void sc_glds4(const void* sbase, unsigned voff, unsigned lds_dst) { unsigned keep;
  asm volatile("s_mov_b32 %0, m0\n\ts_mov_b32 m0, %3\n\ts_nop 0\n\tglobal_load_lds_dword %1, %2\n\ts_mov_b32 m0, %0" : "=&s"(keep) : "v"(voff), "s"(sbase), "s"(lds_dst) : "memory"); }
__device__ __forceinline__ void scan_unit(KArgs P, int chain, int wave, LAS unsigned char* ldsl) {
    const int lane = opaque_lane();
    const int b = chain / 20, h = (chain >> 1) % 10, dir = chain & 1;
    bf16* OB = (bf16*)(P->ws + WS_OB) + (size_t)dir * MROWS * BW;
    const int l16 = lane & 15, g = lane >> 4;
    const unsigned lds0 = (unsigned)(uintptr_t)ldsl;
    const int kind = wave >> 1, half = wave & 1;
    const char* src = (const char*)(P->ws + (kind == 0 ? WS_QT : kind == 1 ? WS_KT : kind == 2 ? WS_KP : WS_VT)) + (kind == 3 ? (size_t)0 : (size_t)dir * SZ_SC) + (kind < 2 ? h * 256 : h * 4096);
    unsigned voff[2];
#pragma unroll
    for (int i = 0; i < 2; ++i) { const int pr = 2 * half + i;
        if (kind < 2) { const int row = 4 * pr + (lane >> 4), logical = (lane & 15) ^ row; voff[i] = (unsigned)(row * (BW * 2) + logical * 16); }
        else voff[i] = (unsigned)(pr * 1024 + lane * 16); }
    const unsigned dst = lds0 + kind * 4096 + 2 * half * 1024, dstdec = lds0 + 16384 + half * 256;
    const char* srcdec = (const char*)(P->ws + WS_DEC) + ((size_t)dir * NCHUNK * BW + h * 128) * 4 + half * 256;
#define SC_CHUNK(ci) (b * 528 + (dir ? ((ci) < 16 ? 15 - (ci) : 543 - (ci)) : (ci)))
#define SC_DMA(ci, so) do { const int ch_ = SC_CHUNK(ci); const char* s_ = src + (size_t)ch_ * 40960; \
        sc_glds16(s_, voff[0], dst + (so)); sc_glds16(s_, voff[1], dst + (so) + 1024); sc_glds4(srcdec + (size_t)ch_ * 5120, (unsigned)lane * 4u, dstdec + (so)); } while (0)
#define SC_NEXT(so) ((so) == (SC_NSLOT - 1) * SC_SLOT ? 0 : (so) + SC_SLOT)
    const int a_qk = l16 * 256, a_kp = 8192 + l16 * 32 + 8 * g, a_vt = 12288 + (16 * wave + l16) * 32 + 8 * g, a_dec = 16384 + 16 * g;
    f32x4 S[8];
#pragma unroll
    for (int j = 0; j < 8; ++j) S[j] = (f32x4){0.f, 0.f, 0.f, 0.f};
    bool keep[4];
#pragma unroll
    for (int i = 0; i < 4; ++i) keep[i] = dir ? (4 * g + i >= l16) : (4 * g + i <= l16);
    SC_DMA(0, 0); SC_DMA(1, SC_SLOT); SC_DMA(2, 2 * SC_SLOT);
    int so = 0, so_n = 3 * SC_SLOT;
    for (int ci = 0; ci < 528; ++ci) {
        if (ci >= 3 && ci + 3 < 528) asm volatile("s_waitcnt vmcnt(18) lgkmcnt(0)\n\ts_barrier" ::: "memory");
        else asm volatile("s_waitcnt vmcnt(0) lgkmcnt(0)\n\ts_barrier" ::: "memory");
        if (ci + 3 < 528) SC_DMA(ci + 3, so_n);
        const LAS unsigned char* sb = ldsl + so;
        bf16x8 qf[4], kf[4]; s16x4 kp[8]; f32x4 dec[8];
#pragma unroll
        for (int j2 = 0; j2 < 4; ++j2) { const int co = ((4 * j2 + g) ^ l16) * 16; qf[j2] = *(const LAS bf16x8*)(sb + a_qk + co); kf[j2] = *(const LAS bf16x8*)(sb + 4096 + a_qk + co); }
#pragma unroll
        for (int j = 0; j < 8; ++j) { kp[j] = *(const LAS s16x4*)(sb + a_kp + 512 * j); dec[j] = *(const LAS f32x4*)(sb + a_dec + 64 * j); }
        const s16x4 vt = *(const LAS s16x4*)(sb + a_vt);
        const int ch = SC_CHUNK(ci);
        f32x4 pt = {0.f, 0.f, 0.f, 0.f};
#pragma unroll
        for (int j2 = 0; j2 < 4; ++j2) pt = __builtin_amdgcn_mfma_f32_16x16x32_bf16(kf[j2], qf[j2], pt, 0, 0, 0);
        v2u paw; paw.x = pkbf(keep[0] ? pt[0] : 0.f, keep[1] ? pt[1] : 0.f); paw.y = pkbf(keep[2] ? pt[2] : 0.f, keep[3] ? pt[3] : 0.f);
        const s16x4 pa = __builtin_bit_cast(s16x4, paw);
        const bf16x8 pa8 = {pa[0], pa[1], pa[2], pa[3], 0, 0, 0, 0}, vt8 = {vt[0], vt[1], vt[2], vt[3], 0, 0, 0, 0};
        f32x4 o = __builtin_amdgcn_mfma_f32_16x16x32_bf16(pa8, vt8, (f32x4){0.f, 0.f, 0.f, 0.f}, 0, 0, 0);
#pragma unroll
        for (int j2 = 0; j2 < 4; ++j2) {
            v4u sw; sw.x = pkbf(S[2 * j2][0], S[2 * j2][1]); sw.y = pkbf(S[2 * j2][2], S[2 * j2][3]); sw.z = pkbf(S[2 * j2 + 1][0], S[2 * j2 + 1][1]); sw.w = pkbf(S[2 * j2 + 1][2], S[2 * j2 + 1][3]);
            o = __builtin_amdgcn_mfma_f32_16x16x32_bf16(qf[j2], __builtin_bit_cast(bf16x8, sw), o, 0, 0, 0);
        }
#pragma unroll
        for (int j = 0; j < 8; ++j) { const bf16x8 kp8 = {kp[j][0], kp[j][1], kp[j][2], kp[j][3], 0, 0, 0, 0}; S[j] = __builtin_amdgcn_mfma_f32_16x16x32_bf16(kp8, vt8, S[j] * dec[j], 0, 0, 0); }
        bf16* op = OB + (size_t)(ch * 16 + 4 * g) * BW + h * 128 + 16 * wave + l16;
#pragma unroll
        for (int i = 0; i < 4; ++i) op[(size_t)i * BW] = (bf16)(pkbf(o[i], 0.f) & 0xffffu);
        so = SC_NEXT(so); so_n = SC_NEXT(so_n);
    }
#undef SC_CHUNK
#undef SC_DMA
#undef SC_NEXT
}
__device__ __forceinline__ void mixer_phase(KArgs P, int l, unsigned char* lds_generic, LAS unsigned char* ldsl, volatile LAS unsigned* MISC, gu32* ctl, int tid, int wave, int lane) {
    static_assert(DEPTH == 2, "conversion unit split");
    const int conv_first = l == 0 ? I_IN : I_LAYER + I_IN, conv_end = l == 0 ? I_LAYER + I_IN : DEPTH * I_LAYER;
    const int n_main = 40 + 768 + 1280, n_att = n_main + (l == 0 ? 64 : 0), total = n_att + (conv_end - conv_first + CONV_UNIT - 1) / CONV_UNIT;
    const bf16* qkv = (const bf16*)(P->ws + WS_QKV); bf16* mix = (bf16*)(P->ws + WS_MIX); bf16* oc = (bf16*)(P->ws + WS_OC);
    for (;;) {
        __syncthreads();
        if (wave == 0 && opaque_lane() == 0) MISC[4] = __hip_atomic_fetch_add((unsigned*)(ctl + CW_WQ + 64 * l), 1u, __ATOMIC_RELAXED, __HIP_MEMORY_SCOPE_AGENT);
        __syncthreads();
        const int u = __builtin_amdgcn_readfirstlane((int)MISC[4]);
        if (u >= total) break;
        if (u >= n_att) {
            LAS float* scr = (LAS float*)(ldsl + wave * 16384); const int ln = opaque_lane();
            conv_run<CONV_PER_WAVE>(P, conv_first + (u - n_att) * CONV_UNIT + wave, 8, conv_end - 1, scr, ln);
            continue; }
#ifndef ATT_SD
#define ATT_SD 1
#endif
#ifndef MIX_MASK
#define MIX_MASK 7
#endif
        if (u < 40) { if (MIX_MASK & 1) scan_unit(P, u, wave, ldsl); if (DBL & 1024) { __syncthreads(); scan_unit(P, u, wave, ldsl); __syncthreads(); scan_unit(P, u, wave, ldsl); } continue; }
        const bool isA = (u < 808) || (u >= n_main && u < n_main + 24);
        if (isA) {
            int hq, b, qrow; int seq;
            if (u < 808) { const int v = u - 40, g = v % 3, qb = (v / 3) & 31, kvh = (v / 96) & 3; b = v / 384; hq = kvh * 3 + g; qrow = CTX + 256 * qb; seq = ROWS_B; }
            else { const int v = u - n_main; hq = v % 12; b = v / 12; qrow = 0; seq = CTX; }
            const int kvh = hq / 3; const size_t rq = (size_t)b * ROWS_B + qrow, rk = (size_t)b * ROWS_B;
            if (MIX_MASK & 2) att::attn_body<128, false>(qkv + rq * INC + C_AQ + 128 * hq, qkv + rk * INC + C_AK + 128 * kvh, qkv + rk * INC + C_AV + 128 * kvh, mix + rq * DM + 128 * hq, DM, seq, (char*)lds_generic, wave);
        } else {
            int m, h, b, qrow; int seq;
            if (u < n_main) { const int v = u - 808; m = v & 1; const int qb = (v >> 1) & 31; h = (v >> 6) % 10; b = v / 640; qrow = CTX + 256 * qb; seq = ROWS_B; }
            else { const int v = u - n_main - 24; m = v & 1; h = (v >> 1) % 10; b = v / 20; qrow = 0; seq = CTX; }
            const size_t rq = (size_t)b * ROWS_B + qrow, rk = (size_t)b * ROWS_B;
            if (MIX_MASK & 4) att::attn_body<64, true>(qkv + rq * INC + C_CQ + 128 * h + 64 * m, qkv + rk * INC + C_CK + 128 * h + 64 * m, qkv + rk * INC + C_CV + 128 * h, oc + rq * 2560 + 128 * (2 * h + m), 2560, seq, (char*)lds_generic, wave);
        }
    }
}
__device__ __forceinline__ void finalize_phase(KArgs P, int l, int gw, int NGW, int lane) {
    const float lam_init = (l == 0) ? 0.2f : 0.35550906759f;
    const float* dl = P->in[14] + l * 256;
    const float lam = __expf(wave_sum(dl[lane] * dl[64 + lane])) - __expf(wave_sum(dl[128 + lane] * dl[192 + lane])) + lam_init;
    const f32x2 gdo = *(const f32x2*)(P->in[15] + l * 128 + 2 * lane), gho = *(const f32x2*)(P->in[11] + l * 128 + 2 * lane);
    const bf16* oc = (const bf16*)(P->ws + WS_OC); const bf16* obf = (const bf16*)(P->ws + WS_OB); const bf16* obb = obf + (size_t)MROWS * BW;
    const bf16* qkv = (const bf16*)(P->ws + WS_QKV); bf16* mix = (bf16*)(P->ws + WS_MIX);
    for (int row = gw; row < MROWS; row += NGW) {
        if (l == DEPTH - 1 && (row % ROWS_B) < CTX) continue;
        unsigned* mrow = (unsigned*)(mix + (size_t)row * DM);
        f32x2 c0[10], c1[10], bf_[10], bb_[10]; unsigned gt[10];
#pragma unroll
        for (int h = 0; h < 10; ++h) { const unsigned t0 = __builtin_nontemporal_load((const unsigned*)(oc + (size_t)row * 2560 + 256 * h + 2 * lane)), t1 = __builtin_nontemporal_load((const unsigned*)(oc + (size_t)row * 2560 + 256 * h + 128 + 2 * lane));
            c0[h] = (f32x2){__uint_as_float(t0 << 16), __uint_as_float(t0 & 0xffff0000u)}; c1[h] = (f32x2){__uint_as_float(t1 << 16), __uint_as_float(t1 & 0xffff0000u)}; }
#pragma unroll
        for (int h = 0; h < 10; ++h) { const unsigned tf = __builtin_nontemporal_load((const unsigned*)(obf + (size_t)row * BW + 128 * h + 2 * lane)), tb = __builtin_nontemporal_load((const unsigned*)(obb + (size_t)row * BW + 128 * h + 2 * lane));
            bf_[h] = (f32x2){__uint_as_float(tf << 16), __uint_as_float(tf & 0xffff0000u)}; bb_[h] = (f32x2){__uint_as_float(tb << 16), __uint_as_float(tb & 0xffff0000u)};
            gt[h] = *(const unsigned*)(qkv + (size_t)row * INC + C_BG + 128 * h + 2 * lane); }
#pragma unroll
        for (int h = 0; h < 10; ++h) {
            const f32x2 d = c0[h] - c1[h] * lam;
            const float r = __builtin_amdgcn_rsqf(wave_sum(d.x * d.x + d.y * d.y) * (1.f / 128.f) + EPS) * (1.0f - lam_init);
            mrow[(2816 + 128 * h) / 2 + lane] = pkbf(d.x * r * gdo.x, d.y * r * gdo.y);
        }
#pragma unroll
        for (int h = 0; h < 10; ++h) {
            const f32x2 a = bf_[h] + bb_[h];
            const float r = __builtin_amdgcn_rsqf(wave_sum(a.x * a.x + a.y * a.y) * (1.f / 128.f) + EPS);
            mrow[(1536 + 128 * h) / 2 + lane] = pkbf(a.x * r * gho.x * silu_f(bflo(gt[h])), a.y * r * gho.y * silu_f(bfhi(gt[h])));
        }
    }
}
__global__ void __launch_bounds__(NTHR, 2) hybrid_fwd(Args args) {
    extern __shared__ __attribute__((aligned(16))) unsigned char lds[];
    LAS unsigned char* ldsl = (LAS unsigned char*)lds;
    volatile LAS unsigned* MISC = (volatile LAS unsigned*)(ldsl + MISC_OFF);
    const int G = gridDim.x, bx = blockIdx.x;
    const int wave_s = __builtin_amdgcn_readfirstlane((int)(threadIdx.x >> 6));
#define PH_IDS const int lane = opaque_lane(), wave = opaque_s(wave_s), tid = wave * 64 + lane; (void)tid; (void)lane; (void)wave; const int lq = opaque_s(l); (void)lq;
#define GW (bx * NWAVES + wave)
#define NGW (G * NWAVES)
#define GTID (bx * NTHR + tid)
#define NGT (G * NTHR)
    for (int u = threadIdx.x; u < (LDS_BYTES - RING_BYTES) / 4; u += NTHR) ((LAS unsigned*)(ldsl + RING_BYTES))[u] = 0u;
    __syncthreads();
    const int lo = args.ph_lo, hi = args.ph_hi;
    XcdBarrier bar; bar.bar = (unsigned*)(args.ws + WS_CTL) + CW_BAR; bar.x = 0; bar.st = nullptr;
    if (hi - lo > 1) bar = xcd_barrier_post((unsigned*)(args.ws + WS_CTL) + CW_BAR, MISC + 8);
#ifndef PH_MASK
#define PH_MASK 0xFFFFFFFFu
#endif
#define IN(k) (lo <= (k) && (k) < hi)
#define EN(k) ((PH_MASK >> (k)) & 1u)
#define SEAM(k) do { if (IN(k) && IN((k) + 1)) xcd_barrier(bar); } while (0)

    if (EN(0) && IN(0)) { const int l = 0; PH_IDS p0_prologue(fresh_args(), ldsl, GW, NGW, wave, lane); if (DBL & 17) { __syncthreads(); p0_prologue(fresh_args(), ldsl, GW, NGW, wave, lane); } } SEAM(0);
    if (EN(1) && IN(1)) { const int l = 0; PH_IDS p1_modreduce(fresh_args(), GTID, NGT); } SEAM(1);

#pragma unroll
    for (int l = 0; l < DEPTH; ++l) {
        const int pb = 2 + 9 * l;
        if (EN(2) && IN(pb + 0)) { PH_IDS norm_phase(fresh_args(), lq, 0, 1, lq == 0, 0, lq > 0, GW, NGW, lane); if (DBL & 33) norm_phase(fresh_args(), lq, 0, 1, lq == 0, 0, lq > 0, GW, NGW, lane); } SEAM(pb + 0);
        if (EN(3) && IN(pb + 1)) {
            const int lq = opaque_s(l); KArgs P = fresh_args(); unsigned char* ws = P->ws;
            pg8::Gemm g{(const pg8::bf16_t*)(ws + WS_HX), (const pg8::bf16_t*)(ws + WS_WIN + lq * SZ_WIN), MROWS, INC, DM}; pg8::PanelOrder S; S.init(INC, G, bx, lq == DEPTH - 1, lq == DEPTH - 1 ? 58 : 0, 0, 0, WGM_IN);
            pg8::EpiInproj E{(pg8::bf16_t*)(ws + WS_QKV), INC, P->in[8] + lq * 128, P->in[9] + lq * 128, P->in[12] + lq * 64, P->in[13] + lq * 64, (LAS float*)(ldsl + RING_BYTES + 2048)};
            pg8::gemm_phase<pg8::EpiInproj, pg8::PanelOrder, true, true>(ldsl, g, S, E, opaque_s(wave_s));
            if (DBL & 2) { __syncthreads(); pg8::gemm_phase<pg8::EpiInproj, pg8::PanelOrder, true, true>(ldsl, g, S, E, opaque_s(wave_s)); }
        } SEAM(pb + 1);
        if (EN(4) && IN(pb + 2)) { PH_IDS scanprep_phase(fresh_args(), lq, GTID, NGT); if (DBL & 65) scanprep_phase(fresh_args(), lq, GTID, NGT); } SEAM(pb + 2);
        if (EN(5) && IN(pb + 3)) { PH_IDS KArgs P = fresh_args(); mixer_phase(P, lq, lds, ldsl, MISC, (gu32*)(P->ws + WS_CTL), tid, wave, lane); if (DBL & 4) { __syncthreads(); mixer_phase(P, lq, lds, ldsl, MISC, (gu32*)(P->ws + WS_CTL) + 2048, tid, wave, lane); } } SEAM(pb + 3);
        if (EN(6) && IN(pb + 4)) { PH_IDS finalize_phase(fresh_args(), lq, GW, NGW, lane); if (DBL & 129) finalize_phase(fresh_args(), lq, GW, NGW, lane); } SEAM(pb + 4);
        if (EN(7) && IN(pb + 5)) {
            const int lq = opaque_s(l); KArgs P = fresh_args(); unsigned char* ws = P->ws; float* xres = (float*)(ws + WS_XRES);
            pg8::Gemm g{(const pg8::bf16_t*)(ws + WS_MIX), (const pg8::bf16_t*)(ws + WS_WOUT + lq * SZ_WOUT), MROWS, DM, DM}; pg8::PanelOrder S; S.init(DM, G, bx, 1, 0, lq != DEPTH - 1, DM / 64, WGM_OUT);
            pg8::EpiResGate E{xres, xres, (const float*)(ws + WS_MOD) + (size_t)lq * 3 * 24576, 2 * DM, 0, lq == 0, P->in[0], P->in[2], (float*)(ws + WS_PART)};
            if (DBL & 256) { pg8::EpiResGate E2 = E; E2.out = (float*)(ws + WS_OC); pg8::gemm_phase<pg8::EpiResGate, pg8::PanelOrder, true, true>(ldsl, g, S, E2, opaque_s(wave_s)); __syncthreads(); }
            pg8::gemm_phase<pg8::EpiResGate, pg8::PanelOrder, true, true>(ldsl, g, S, E, opaque_s(wave_s));
        } SEAM(pb + 5);
        if (EN(8) && IN(pb + 6)) { PH_IDS norm_phase(fresh_args(), lq, 3, 4, 0, lq == DEPTH - 1, lq < DEPTH - 1, GW, NGW, lane); if (DBL & 33) norm_phase(fresh_args(), lq, 3, 4, 0, lq == DEPTH - 1, lq < DEPTH - 1, GW, NGW, lane); } SEAM(pb + 6);
        if (EN(9) && IN(pb + 7)) {
            const int lq = opaque_s(l); KArgs P = fresh_args(); unsigned char* ws = P->ws;
            pg8::Gemm g{(const pg8::bf16_t*)(ws + WS_HX), (const pg8::bf16_t*)(ws + WS_WGU + lq * SZ_WGU), MROWS, 2 * DFF, DM}; pg8::PanelOrder S; S.init(2 * DFF, G, bx, lq == DEPTH - 1, 0, 0, 0, WGM_GU);
            pg8::EpiSwiglu E{(pg8::bf16_t*)(ws + WS_QKV), DFF};
            pg8::gemm_phase<pg8::EpiSwiglu, pg8::PanelOrder, true, true>(ldsl, g, S, E, opaque_s(wave_s));
            if (DBL & 8) { __syncthreads(); pg8::gemm_phase<pg8::EpiSwiglu, pg8::PanelOrder, true, true>(ldsl, g, S, E, opaque_s(wave_s)); }
        } SEAM(pb + 7);
        if (EN(10) && IN(pb + 8)) {
            const int lq = opaque_s(l); KArgs P = fresh_args(); unsigned char* ws = P->ws; float* xres = (float*)(ws + WS_XRES);
            pg8::Gemm g{(const pg8::bf16_t*)(ws + WS_QKV), (const pg8::bf16_t*)(ws + WS_WDN + lq * SZ_WDN), MROWS, DM, DFF}; pg8::PanelOrder S; S.init(DM, G, bx, 1, 0, lq != DEPTH - 1, DFF / 64, WGM_DN);
            pg8::EpiResGate E{xres, (lq == DEPTH - 1) ? P->out : xres, (const float*)(ws + WS_MOD) + (size_t)lq * 3 * 24576, 5 * DM, (lq == DEPTH - 1) ? 1 : 0, 0, nullptr, nullptr, (float*)(ws + WS_PART)};
            if (DBL & 512) { pg8::EpiResGate E2 = E; E2.out = (float*)(ws + WS_OC); E2.final_out = 0; pg8::gemm_phase<pg8::EpiResGate, pg8::PanelOrder, true, true>(ldsl, g, S, E2, opaque_s(wave_s)); __syncthreads(); }
            pg8::gemm_phase<pg8::EpiResGate, pg8::PanelOrder, true, true>(ldsl, g, S, E, opaque_s(wave_s));
        } SEAM(pb + 8);
    }
#undef IN
#undef SEAM
}

extern "C" void kernel_launch(void* const* d_in, const int* in_sizes, int n_in, void* d_out, int out_size, void* d_ws, size_t ws_size, hipStream_t stream) {
    static int grid = 0;
    if (grid == 0) {
        if (n_in != 19 || out_size != NB * SEQ * DM || ws_size < WS_END) { fprintf(stderr, "kernel_launch: shape/workspace mismatch: n_in %d out %d ws %zu (need %zu)\n", n_in, out_size, ws_size, (size_t)WS_END); grid = -1; return; }
        int dev = 0, cus = 0, per_cu = 0;
        if (hipGetDevice(&dev) != hipSuccess || hipDeviceGetAttribute(&cus, hipDeviceAttributeMultiprocessorCount, dev) != hipSuccess) { grid = -1; return; }
        if (hipFuncSetAttribute((const void*)hybrid_fwd, hipFuncAttributeMaxDynamicSharedMemorySize, LDS_BYTES) != hipSuccess) { fprintf(stderr, "kernel_launch: hipFuncSetAttribute failed\n"); grid = -1; return; }
        if (hipOccupancyMaxActiveBlocksPerMultiprocessor(&per_cu, (const void*)hybrid_fwd, NTHR, LDS_BYTES) != hipSuccess || per_cu < 1) { fprintf(stderr, "kernel_launch: occupancy query says %d\n", per_cu); }
        (void)hipGetLastError();
        grid = cus;
    }
    if (grid < 0) return;
    if (hipMemsetAsync((char*)d_ws + WS_CTL, 0, CTL_ZERO_BYTES, stream) != hipSuccess) return;
    Args a{};
    for (int i = 0; i < 19; ++i) a.in[i] = (const float*)d_in[i];
    a.out = (float*)d_out; a.ws = (unsigned char*)d_ws;
#if MK_ONE_LAUNCH
    a.ph_lo = 0; a.ph_hi = N_PHASES;
    hipLaunchKernelGGL(hybrid_fwd, dim3(grid), dim3(NTHR), LDS_BYTES, stream, a);
#else
    for (int p = 0; p < N_PHASES; ++p) { a.ph_lo = p; a.ph_hi = p + 1; hipLaunchKernelGGL(hybrid_fwd, dim3(grid), dim3(NTHR), LDS_BYTES, stream, a); }
#endif
}
```
